# Optimizing an MI355X kernel written in HIP

```python
import jax, jax.numpy as jnp
from jax import lax
import numpy as np

D_MODEL = 2048
BATCH = 4
SEQ = 2048
DEPTH = 2

GRID_W = 64
CTX_LEN = 256

N_HEADS = 16
N_KV_HEADS = 4
HEAD_DIM = D_MODEL // N_HEADS
Q_BLOCK = 128
ROPE_THETA = 10000.0
CHUNK = 128
GMLP_WIDTH = D_MODEL // 2
GMLP_GROUPS = 8
GMLP_GROUP_DIM = GMLP_WIDTH // GMLP_GROUPS
CONV_WIDTH = D_MODEL // 2
CONV_K = 3
D_FF = ((8 * D_MODEL // 3 + 127) // 128) * 128
FFN_CONV_K = 3
EPS = 1e-6

Q_DIM = N_HEADS * HEAD_DIM
KV_DIM = N_KV_HEADS * HEAD_DIM
N_BRANCH = 3
SPLITS = (Q_DIM, KV_DIM, KV_DIM, 2 * GMLP_WIDTH, CONV_WIDTH, CONV_WIDTH, CONV_WIDTH, N_BRANCH * D_MODEL)
IN_DIM = sum(SPLITS)

kernel_name = "hybrid_gmlp_shortconv_gqa_dit_block"


def rms_norm(x, g):
    xf = x.astype(jnp.float32)
    y = xf * lax.rsqrt(jnp.mean(xf * xf, axis=-1, keepdims=True) + EPS)
    return (y * g.astype(jnp.float32)).astype(x.dtype)


def modulate(h, shift, scale):
    return h * (1 + scale) + shift


def dwconv_centred(x, w):
    K = w.shape[0]
    pad = K // 2
    L = x.shape[1]
    xp = jnp.pad(x, ((0, 0), (pad, pad), (0, 0)))
    out = xp[:, 0:L, :] * w[0]
    for k in range(1, K):
        out = out + xp[:, k:k + L, :] * w[k]
    return out


def split_proj(z):
    points = np.cumsum(SPLITS)[:-1].tolist()
    return jnp.split(z, points, axis=-1)


def axial_rope_tables(L):
    rows = L // GRID_W
    row = jnp.repeat(jnp.arange(rows, dtype=jnp.float32), GRID_W)
    col = jnp.tile(jnp.arange(GRID_W, dtype=jnp.float32), rows)
    n_freq = HEAD_DIM // 4
    inv_freq = ROPE_THETA ** (-jnp.arange(n_freq, dtype=jnp.float32) / n_freq)
    ang = jnp.stack([row, col], axis=-1)[..., None] * inv_freq
    return jnp.cos(ang), jnp.sin(ang)


def apply_axial_rope(x, cos, sin):
    B, L, H, _ = x.shape
    xr = x.astype(jnp.float32).reshape(B, L, H, 2, 2, HEAD_DIM // 4)
    x1, x2 = xr[..., 0, :], xr[..., 1, :]
    cs, sn = cos[None, :, None], sin[None, :, None]
    out = jnp.stack([x1 * cs - x2 * sn, x2 * cs + x1 * sn], axis=-2)
    return out.reshape(B, L, H, HEAD_DIM).astype(x.dtype)


def qkv_heads(q, k, v, g_q, g_k, rope=None):
    B, L = q.shape[:2]
    q = rms_norm(q.reshape(B, L, N_HEADS, HEAD_DIM), g_q)
    k = rms_norm(k.reshape(B, L, N_KV_HEADS, HEAD_DIM), g_k)
    v = v.reshape(B, L, N_KV_HEADS, HEAD_DIM)
    if rope is not None:
        q = apply_axial_rope(q, *rope)
        k = apply_axial_rope(k, *rope)
    return q, k, v


def attend(qg, keys, vals):
    s = jnp.einsum('bqkgd,bskd->bkgqs', qg, keys).astype(jnp.float32) * (HEAD_DIM ** -0.5)
    p = jax.nn.softmax(s, axis=-1).astype(vals.dtype)
    return jnp.einsum('bkgqs,bskd->bqkgd', p, vals)


def context_attention(q, k, v):
    B, Lc = q.shape[:2]
    qg = q.reshape(B, Lc, N_KV_HEADS, N_HEADS // N_KV_HEADS, HEAD_DIM)
    return attend(qg, k, v).reshape(B, Lc, Q_DIM)


def latent_attention(q, k, v, k_ctx, v_ctx):
    B, L = q.shape[:2]
    keys = jnp.concatenate([k, k_ctx], axis=1)
    vals = jnp.concatenate([v, v_ctx], axis=1)
    qb = q.reshape(B, L // Q_BLOCK, Q_BLOCK, N_KV_HEADS, N_HEADS // N_KV_HEADS, HEAD_DIM)
    qb = qb.transpose(1, 0, 2, 3, 4, 5)
    o = lax.map(lambda qi: attend(qi, keys, vals), qb)
    return o.transpose(1, 0, 2, 3, 4, 5).reshape(B, L, Q_DIM)


def chunk_gmlp(z, w_s, b_s, g_v):
    z = jax.nn.gelu(z)
    u, v = jnp.split(z, 2, axis=-1)
    v = rms_norm(v, g_v)
    B, L, _ = v.shape
    vc = v.reshape(B, L // CHUNK, CHUNK, GMLP_GROUPS, GMLP_GROUP_DIM)
    mixed = jnp.einsum('gpq,bnqgc->bnpgc', w_s, vc) + b_s.T[None, None, :, :, None]
    return u * mixed.reshape(B, L, GMLP_WIDTH)


def short_conv(b_gate, c_gate, h, w_conv):
    return b_gate * dwconv_centred(c_gate * h, w_conv)


def merge_branches(parts, attn, w_s, b_s, g_v, w_sconv, w_pa, w_pb, w_pc, w_o):
    _, _, _, z_a, b_gate, c_gate, h_b, gates = parts
    y_a = chunk_gmlp(z_a, w_s, b_s, g_v)
    y_b = short_conv(b_gate, c_gate, h_b, w_sconv)
    g_a, g_b, g_c = jnp.split(jax.nn.sigmoid(gates), N_BRANCH, axis=-1)
    m = g_a * (y_a @ w_pa) + g_b * (y_b @ w_pb) + g_c * (attn @ w_pc)
    return m @ w_o


def conv_ffn(h, w_up, w_conv, w_down):
    u = dwconv_centred(h @ w_up, w_conv)
    a, b = jnp.split(u, 2, axis=-1)
    return (jax.nn.silu(a) * b) @ w_down


def setup_inputs(seed: int = 0) -> dict:
    key = jax.random.key(seed)
    ks = jax.random.split(key, 32)
    f32 = jnp.float32

    def nrm(k, shape, scale):
        return jax.random.normal(k, shape, f32) * scale

    def gain(k, shape):
        return 1.0 + 0.02 * jax.random.normal(k, shape, f32)

    D = D_MODEL
    return {
        "x": nrm(ks[0], (BATCH, SEQ, D), 1.0),
        "c": nrm(ks[1], (BATCH, D), 1.0),
        "ctx": nrm(ks[2], (BATCH, CTX_LEN, D), 1.0),
        "c_ctx": nrm(ks[3], (D,), 1.0),
        "w_ada": nrm(ks[4], (DEPTH, D, 6 * D), 0.5 * D ** -0.5),
        "b_ada": nrm(ks[5], (DEPTH, 6 * D), 0.01),
        "g_mix": gain(ks[6], (DEPTH, D)),
        "w_in": nrm(ks[7], (DEPTH, D, IN_DIM), D ** -0.5),
        "g_q": gain(ks[8], (DEPTH, HEAD_DIM)),
        "g_k": gain(ks[9], (DEPTH, HEAD_DIM)),
        "w_gmlp": nrm(ks[10], (DEPTH, GMLP_GROUPS, CHUNK, CHUNK), CHUNK ** -0.5),
        "b_gmlp": gain(ks[11], (DEPTH, GMLP_GROUPS, CHUNK)),
        "g_gmlp_v": gain(ks[12], (DEPTH, GMLP_WIDTH)),
        "w_sconv": nrm(ks[13], (DEPTH, CONV_K, CONV_WIDTH), CONV_K ** -0.5),
        "w_pa": nrm(ks[14], (DEPTH, GMLP_WIDTH, D), GMLP_WIDTH ** -0.5),
        "w_pb": nrm(ks[15], (DEPTH, CONV_WIDTH, D), CONV_WIDTH ** -0.5),
        "w_pc": nrm(ks[16], (DEPTH, Q_DIM, D), Q_DIM ** -0.5),
        "w_o": nrm(ks[17], (DEPTH, D, D), D ** -0.5),
        "g_ffn": gain(ks[18], (DEPTH, D)),
        "w_up": nrm(ks[19], (DEPTH, D, 2 * D_FF), D ** -0.5),
        "w_ffn_conv": nrm(ks[20], (DEPTH, FFN_CONV_K, 2 * D_FF), FFN_CONV_K ** -0.5),
        "w_down": nrm(ks[21], (DEPTH, D_FF, D), D_FF ** -0.5),
        "g_final": gain(ks[22], (D,)),
    }


def reference(x, c, ctx, c_ctx, w_ada, b_ada, g_mix, w_in, g_q, g_k, w_gmlp, b_gmlp, g_gmlp_v,
              w_sconv, w_pa, w_pb, w_pc, w_o, g_ffn, w_up, w_ffn_conv, w_down, g_final):
    L = x.shape[1]
    rope = axial_rope_tables(L)
    xc = ctx
    for l in range(DEPTH):
        last = l == DEPTH - 1
        mod_x = jax.nn.silu(c) @ w_ada[l] + b_ada[l]
        mod_c = jax.nn.silu(c_ctx) @ w_ada[l] + b_ada[l]
        sh1, sc1, gt1, sh2, sc2, gt2 = jnp.split(mod_x[:, None, :], 6, axis=-1)
        csh1, csc1, cgt1, csh2, csc2, cgt2 = jnp.split(mod_c, 6, axis=-1)
        mix_args = (w_gmlp[l], b_gmlp[l], g_gmlp_v[l], w_sconv[l], w_pa[l], w_pb[l], w_pc[l], w_o[l])

        hc = modulate(rms_norm(xc, g_mix[l]), csh1, csc1)
        hx = modulate(rms_norm(x, g_mix[l]), sh1, sc1)
        pc = split_proj(hc @ w_in[l])
        px = split_proj(hx @ w_in[l])
        qc, kc, vc = qkv_heads(pc[0], pc[1], pc[2], g_q[l], g_k[l])
        qx, kx, vx = qkv_heads(px[0], px[1], px[2], g_q[l], g_k[l], rope)
        attn_x = latent_attention(qx, kx, vx, kc, vc)
        x = x + gt1 * merge_branches(px, attn_x, *mix_args)

        fx = modulate(rms_norm(x, g_ffn[l]), sh2, sc2)
        x = x + gt2 * conv_ffn(fx, w_up[l], w_ffn_conv[l], w_down[l])

        if not last:
            attn_c = context_attention(qc, kc, vc)
            xc = xc + cgt1 * merge_branches(pc, attn_c, *mix_args)
            fc = modulate(rms_norm(xc, g_ffn[l]), csh2, csc2)
            xc = xc + cgt2 * conv_ffn(fc, w_up[l], w_ffn_conv[l], w_down[l])

    return rms_norm(x, g_final)
```

```cpp
#include <hip/hip_runtime.h>
#include <hip/hip_cooperative_groups.h>
#include <cstdio>
#include <cstdint>
namespace cg = cooperative_groups;

#define LAS __attribute__((address_space(3)))
typedef unsigned short bf16_t;
typedef short bf16x8 __attribute__((ext_vector_type(8)));
typedef short s16x4 __attribute__((ext_vector_type(4)));
typedef float f32x2 __attribute__((ext_vector_type(2)));
typedef float f32x4 __attribute__((ext_vector_type(4)));
typedef float f32x16 __attribute__((ext_vector_type(16)));
typedef unsigned u32x2 __attribute__((ext_vector_type(2)));
typedef unsigned u32x4 __attribute__((ext_vector_type(4)));

constexpr int DM = 2048, TL = 8192, TC = 1024, TT = 9216, SEQL = 2048, CTXL = 256, SKV = 2304;
constexpr int IN_DIM = 14336, DFF = 5504, DFF2 = 11008, MODW = 12288;
constexpr int OFF_K = 2048, OFF_V = 2560, OFF_GU = 3072, OFF_GV = 4096, OFF_CB = 5120, OFF_CC = 6144, OFF_CH = 7168, OFF_GATE = 8192;
constexpr float EPS = 1e-6f;
constexpr int NTHR = 512;
constexpr int LDS_GEMM = 131072, LDS_BYTES = LDS_GEMM + 32;
constexpr int XCD_BAR_WORDS_C = 3456;

constexpr size_t SZ_WIN = (size_t)IN_DIM * DM * 2, SZ_WM = (size_t)4 * DM * 1024 * 2, SZ_WO = (size_t)DM * DM * 2, SZ_WUP = (size_t)DFF2 * DM * 2, SZ_WDN = (size_t)DM * DFF * 2;
constexpr size_t WS_WIN = 0;
constexpr size_t WS_WM = WS_WIN + 2 * SZ_WIN;
constexpr size_t WS_WO = WS_WM + 2 * SZ_WM;
constexpr size_t WS_WUP = WS_WO + 2 * SZ_WO;
constexpr size_t WS_WDN = WS_WUP + 2 * SZ_WUP;
constexpr size_t WS_MOD = WS_WDN + 2 * SZ_WDN;
constexpr size_t WS_XW = WS_MOD + (size_t)2 * 5 * MODW * 4;
constexpr size_t WS_H = WS_XW + (size_t)TT * DM * 4;
constexpr size_t WS_Z = WS_H + (size_t)TT * DM * 2;
constexpr size_t WS_AM = WS_Z + (size_t)TT * IN_DIM * 2;
constexpr size_t WS_Q = WS_AM + (size_t)4 * TT * 1024 * 2;
constexpr size_t WS_K = WS_Q + (size_t)TT * DM * 2;
constexpr size_t WS_V = WS_K + (size_t)4 * SKV * 512 * 2;
constexpr size_t WS_VN = WS_V + (size_t)4 * SKV * 512 * 2;
constexpr size_t WS_BAR = WS_VN + (size_t)TT * 1024 * 2;
constexpr size_t WS_ROPE = ((WS_BAR + (size_t)XCD_BAR_WORDS_C * 4 + 255) / 256) * 256;
constexpr size_t WS_EDGE = WS_ROPE + (size_t)SEQL * 64 * 2 * 4;
constexpr size_t WS_END = WS_EDGE + (size_t)(TT / 64) * 2 * 2 * 2 * DFF * 4;
static_assert((size_t)TT * DFF * 2 <= (size_t)4 * TT * 1024 * 2 + (size_t)TT * DM * 2, "G alias");

struct Params {
    const float* in[23];
    float* out;
    unsigned char* ws;
    int ph_lo, ph_hi;
};

__device__ __forceinline__ unsigned cvt_pk_bf16(float lo, float hi) { unsigned r; asm volatile("v_cvt_pk_bf16_f32 %0, %1, %2" : "=v"(r) : "v"(lo), "v"(hi)); return r; }
__device__ __forceinline__ float bf2f(bf16_t b) { return __uint_as_float(((unsigned)b) << 16); }
__device__ __forceinline__ bf16_t f2bf(float f) { return (bf16_t)(cvt_pk_bf16(f, 0.f) & 0xffffu); }
__device__ __forceinline__ float wave_sum(float v, int lane) {
#pragma unroll
    for (int o = 32; o; o >>= 1) v += __int_as_float(__builtin_amdgcn_ds_bpermute((lane ^ o) << 2, __float_as_int(v)));
    return v;
}
__device__ __forceinline__ float lo_f(unsigned w) { return __uint_as_float(w << 16); }
__device__ __forceinline__ float hi_f(unsigned w) { return __uint_as_float(w & 0xffff0000u); }
__device__ __forceinline__ float gelu_tanh(float x) {
    const float y = 0.7978845608028654f * (x + 0.044715f * x * x * x);
    const float e = __expf(2.f * y);
    const float th = 1.f - 2.f / (e + 1.f);
    return 0.5f * x * (1.f + th);
}
__device__ __forceinline__ float sigmoidf_(float x) { return 1.f / (1.f + __expf(-x)); }

namespace pg8 {
constexpr int BM = 256, BK = 64, HALF = 128, HTB = HALF * BK * 2, STAGE_BYTES = 8 * HTB, NXCD = 8, WGM = 8;
__host__ __device__ __forceinline__ int lds_byte(int r, int c) { const int st = (r >> 4) * 2 + (c >> 5), rr = r & 15, cc = c & 31, ob = rr * 64 + cc * 2; return st * 1024 + (ob ^ (((ob >> 9) & 1) << 5)); }
__host__ __device__ __forceinline__ void stage_rc(int b, int& R, int& C) { const int st = b / 1024, sb = b % 1024, swz = sb ^ (((sb >> 9) & 1) << 5); R = (st >> 1) * 16 + swz / 64; C = (st & 1) * 32 + (swz % 64) / 2; }
__host__ __device__ __forceinline__ int perm32(int rho) { const int n = rho >> 4, i = rho & 15; return 8 * (i >> 2) + 4 * n + (i & 3); }

struct Unit { int pm, pn, seg, ks; };

struct Order {
    int nM, nN, nwg, G, c, nseg;
    int xM0, xN0, xnM, xnN, xsplit, xseg, ntf, sbase, sthr;
    const char* A; const char* B; const char* A2; size_t tstep, segA, segB, a2pn;
    unsigned* wait_cnt; unsigned wait_need;
    __device__ void init(int M, int N, int K, int G_, int c_, const void* A_, const void* B_) {
        nM = M / BM; nN = N / BM; nwg = nM * nN; G = G_; c = c_; nseg = 1; xM0 = xN0 = xnM = xnN = 0; xsplit = 1; xseg = 0; A2 = nullptr; a2pn = 0; wait_cnt = nullptr; wait_need = 0; ntf = K / BK; sbase = ((ntf / 8) & ~1); sthr = 8 - (ntf - 8 * sbase) / 2; A = (const char*)A_; B = (const char*)B_; tstep = (size_t)BM * K * 2; segA = segB = 0; }
    __device__ bool next(int i, Unit& u) const {
        const int ti = i / nseg; u.seg = i - ti * nseg; u.ks = -1;
        const long L = (long)ti * G + c;
        if (L < nwg) {
            int wgid = (int)L; { const int q = nwg / NXCD, r = nwg % NXCD, xcd = wgid % NXCD, off = wgid / NXCD; wgid = (xcd < r ? xcd * (q + 1) : r * (q + 1) + (xcd - r) * q) + off; }
            const int nig = WGM * nN, gid = wgid / nig, fm = gid * WGM, gsz = (nM - fm) < WGM ? (nM - fm) : WGM;
            u.pm = fm + ((wgid % nig) % gsz); u.pn = (wgid % nig) / gsz; return true;
        }
        const int e = (int)(L - nwg);
        if (xseg) { if (u.seg != 0) return false;
            if (e < xnM * xnN * xseg) { const int t = e / xseg; u.seg = e - t * xseg; u.pm = xM0 + t % xnM; u.pn = xN0 + t / xnM; u.ks = 0; return true; }
            return false; }
        if (e < xnM * xnN * xsplit) { const int t = e / xsplit; u.pm = xM0 + t % xnM; u.pn = xN0 + t / xnM; if (xsplit > 1) u.ks = e - t * xsplit; return true; }
        return false;
    }
    __device__ __forceinline__ int nt(const Unit& u) const { return (u.ks < 0 || xsplit == 1) ? ntf : sbase + (u.ks >= sthr ? 2 : 0); }
    __device__ __forceinline__ size_t kofs(const Unit& u) const { return (u.ks < 0 || xsplit == 1) ? (size_t)0 : (size_t)(u.ks * sbase + (u.ks > sthr ? 2 * (u.ks - sthr) : 0)) * (BK * 2); }
    __device__ __forceinline__ const char* aptr(const Unit& u) const { return (A2 != nullptr && u.ks >= 0) ? A2 + (size_t)u.pn * a2pn + (size_t)(u.pm - xM0) * tstep + kofs(u) : A + (size_t)u.seg * segA + (size_t)u.pm * tstep + kofs(u); }
    __device__ __forceinline__ void a_ready(const Unit& u, int tid) const {
        if (wait_cnt == nullptr || u.ks < 0) return;
        if (tid < 64) {
            unsigned sp = 0;
            while ((unsigned)__builtin_amdgcn_readfirstlane(__hip_atomic_load(wait_cnt, __ATOMIC_RELAXED, __HIP_MEMORY_SCOPE_AGENT)) < wait_need) { __builtin_amdgcn_s_sleep(2); if (++sp > (1u << 20)) break; }
            __builtin_amdgcn_fence(__ATOMIC_ACQUIRE, "agent");
            asm volatile("s_waitcnt vmcnt(0)" ::: "memory");
        }
        asm volatile("" ::: "memory"); __builtin_amdgcn_s_barrier(); asm volatile("" ::: "memory");
    }
    __device__ __forceinline__ const char* bptr(const Unit& u) const { return B + (size_t)u.seg * segB + (size_t)u.pn * tstep + kofs(u); }
};

struct EpiBf16 {
    static constexpr bool PERM = true;
    bf16_t* O; int ldc; float* PART;
    bf16_t* U; bf16_t* V;
    __device__ __forceinline__ bool zero_after(const Unit&) const { return true; }
    __device__ __forceinline__ void operator()(f32x4 (&acc)[2][2][4][2], const Unit& u, int wr, int wc, int fr, int fq) const {
        const int row0 = u.pm * BM + wr * 64 + fr, col0 = u.pn * BM + wc * 32 + 8 * fq;
        if (u.ks >= 0) {
            float* pb = PART + ((size_t)u.ks * TC + (size_t)(row0 - TL)) * 1024 + (col0 - OFF_K);
#pragma unroll
            for (int ai = 0; ai < 2; ++ai)
#pragma unroll
                for (int m = 0; m < 4; ++m)
#pragma unroll
                    for (int bj = 0; bj < 2; ++bj) { float* q = pb + (size_t)(ai * HALF + m * 16) * 1024 + bj * HALF; *(f32x4*)q = acc[ai][bj][m][0]; *(f32x4*)(q + 4) = acc[ai][bj][m][1]; }
            return;
        }
        bf16_t* base = O; size_t ld = (size_t)ldc; int coff = col0, roff = 0; bool gel = false;
        if (u.pn >= 12 && u.pn < 16) { base = U; ld = 1024; coff = col0 - OFF_GU; gel = true; }
        else if (u.pn == 10 || u.pn == 11) { base = V; ld = 512; coff = col0 - OFF_V; roff = u.pm < 32 ? (u.pm >> 3) * 256 : 2048 * (u.pm - 32) - 6144; }
#pragma unroll
        for (int ai = 0; ai < 2; ++ai)
#pragma unroll
            for (int m = 0; m < 4; ++m) { bf16_t* rowp = base + (size_t)(row0 + ai * HALF + m * 16 + roff) * ld + coff;
#pragma unroll
                for (int bj = 0; bj < 2; ++bj) { f32x4 v0 = acc[ai][bj][m][0], v1 = acc[ai][bj][m][1];
                    if (gel) {
#pragma unroll
                        for (int i = 0; i < 4; ++i) { v0[i] = gelu_tanh(v0[i]); v1[i] = gelu_tanh(v1[i]); } }
                    u32x4 w; w.x = cvt_pk_bf16(v0[0], v0[1]); w.y = cvt_pk_bf16(v0[2], v0[3]); w.z = cvt_pk_bf16(v1[0], v1[1]); w.w = cvt_pk_bf16(v1[2], v1[3]);
                    *(u32x4*)(rowp + bj * HALF) = w; } }
    }
};
struct EpiResid {
    static constexpr bool PERM = true;
    bf16_t* X; float* PART; const float* Xf32; const float* mod; int gate_off;
    __device__ __forceinline__ bool zero_after(const Unit&) const { return true; }
    __device__ __forceinline__ void operator()(f32x4 (&acc)[2][2][4][2], const Unit& u, int wr, int wc, int fr, int fq) const {
        const int row0 = u.pm * BM + wr * 64 + fr, col0 = u.pn * BM + wc * 32 + 8 * fq;
        const int r = u.pm < 32 ? (u.pm >> 3) : 4;
        const float* gt = mod + (size_t)r * MODW + gate_off + col0;
        f32x4 gv[2][2];
#pragma unroll
        for (int bj = 0; bj < 2; ++bj)
#pragma unroll
            for (int n = 0; n < 2; ++n) gv[bj][n] = *(const f32x4*)(gt + bj * HALF + 4 * n);
        if (u.ks >= 0) {
            float* pb = PART + ((size_t)u.ks * TC + (size_t)(row0 - TL)) * DM + col0;
#pragma unroll
            for (int ai = 0; ai < 2; ++ai)
#pragma unroll
                for (int m = 0; m < 4; ++m)
#pragma unroll
                    for (int bj = 0; bj < 2; ++bj) { float* q = pb + (size_t)(ai * HALF + m * 16) * DM + bj * HALF;
                        *(f32x4*)q = gv[bj][0] * acc[ai][bj][m][0]; *(f32x4*)(q + 4) = gv[bj][1] * acc[ai][bj][m][1]; }
            return;
        }
#pragma unroll
        for (int ai = 0; ai < 2; ++ai)
#pragma unroll
            for (int m = 0; m < 4; ++m) { const size_t ro = (size_t)(row0 + ai * HALF + m * 16) * DM + col0;
#pragma unroll
                for (int bj = 0; bj < 2; ++bj) { f32x4 x0, x1;
                    if (Xf32 != nullptr) { x0 = *(const f32x4*)(Xf32 + ro + bj * HALF); x1 = *(const f32x4*)(Xf32 + ro + bj * HALF + 4); }
                    else { const u32x4 xb = *(const u32x4*)(X + ro + bj * HALF);
                        x0 = (f32x4){lo_f(xb.x), hi_f(xb.x), lo_f(xb.y), hi_f(xb.y)}; x1 = (f32x4){lo_f(xb.z), hi_f(xb.z), lo_f(xb.w), hi_f(xb.w)}; }
                    x0 += gv[bj][0] * acc[ai][bj][m][0]; x1 += gv[bj][1] * acc[ai][bj][m][1];
                    u32x4 w; w.x = cvt_pk_bf16(x0[0], x0[1]); w.y = cvt_pk_bf16(x0[2], x0[3]); w.z = cvt_pk_bf16(x1[0], x1[1]); w.w = cvt_pk_bf16(x1[2], x1[3]);
                    *(u32x4*)(X + ro + bj * HALF) = w; } }
    }
};
__device__ __forceinline__ float dppf(float oldv, float src, const int ctrl) {
    if (ctrl == 0x111) return __int_as_float(__builtin_amdgcn_update_dpp(__float_as_int(oldv), __float_as_int(src), 0x111, 0xf, 0xf, false));
    if (ctrl == 0x101) return __int_as_float(__builtin_amdgcn_update_dpp(__float_as_int(oldv), __float_as_int(src), 0x101, 0xf, 0xf, false));
    if (ctrl == 0x121) return __int_as_float(__builtin_amdgcn_update_dpp(__float_as_int(oldv), __float_as_int(src), 0x121, 0xf, 0xf, false));
    return __int_as_float(__builtin_amdgcn_update_dpp(__float_as_int(oldv), __float_as_int(src), 0x12F, 0xf, 0xf, false));
}
struct EpiFfn {
    static constexpr bool PERM = true;
    bf16_t* G; float* EDGE; const float* wcv;
    __device__ __forceinline__ bool zero_after(const Unit&) const { return true; }
    __device__ __forceinline__ void operator()(f32x4 (&acc)[2][2][4][2], const Unit& u, int wr, int wc, int fr, int fq) const {
        f32x4 wall[2][2][3];
#pragma unroll
        for (int n = 0; n < 2; ++n)
#pragma unroll
            for (int k = 0; k < 3; ++k) { const int jj = u.pn * 128 + wc * 32 + 8 * fq + 4 * n;
                wall[n][0][k] = *(const f32x4*)(wcv + (size_t)k * DFF2 + jj); wall[n][1][k] = *(const f32x4*)(wcv + (size_t)k * DFF2 + DFF + jj); }
#pragma unroll
        for (int n = 0; n < 2; ++n) {
            const int j0 = u.pn * 128 + wc * 32 + 8 * fq + 4 * n;
            f32x4 wa[3], wb[3];
#pragma unroll
            for (int k = 0; k < 3; ++k) { wa[k] = wall[n][0][k]; wb[k] = wall[n][1][k]; }
#pragma unroll
            for (int ai = 0; ai < 2; ++ai) {
                const int rb = u.pm * BM + ai * HALF + wr * 64, blk = rb >> 6;
#pragma unroll
                for (int m = 0; m < 4; ++m) {
                    f32x4 o, pa_, pb_;
#pragma unroll
                    for (int i = 0; i < 4; ++i) {
                        const float a0 = acc[ai][0][m][n][i], b0 = acc[ai][1][m][n][i];
                        float ap = 0.f, an = 0.f, bp = 0.f, bn = 0.f;
                        if (m > 0) { ap = dppf(0.f, acc[ai][0][m - 1][n][i], 0x121); bp = dppf(0.f, acc[ai][1][m - 1][n][i], 0x121); }
                        if (m < 3) { an = dppf(0.f, acc[ai][0][m + 1][n][i], 0x12F); bn = dppf(0.f, acc[ai][1][m + 1][n][i], 0x12F); }
                        ap = dppf(ap, a0, 0x111); bp = dppf(bp, b0, 0x111);
                        an = dppf(an, a0, 0x101); bn = dppf(bn, b0, 0x101);
                        const float ca = wa[0][i] * ap + wa[1][i] * a0 + wa[2][i] * an, cb = wb[0][i] * bp + wb[1][i] * b0 + wb[2][i] * bn;
                        pa_[i] = ca; pb_[i] = cb;
                        o[i] = ca * __builtin_amdgcn_rcpf(1.f + __expf(-ca)) * cb; }
                    u32x2 w; w.x = cvt_pk_bf16(o[0], o[1]); w.y = cvt_pk_bf16(o[2], o[3]);
                    *(u32x2*)(G + (size_t)(rb + m * 16 + fr) * DFF + j0) = w;
                    if ((m == 0 && fr == 0) || (m == 3 && fr == 15)) {
                        float* eb = EDGE + (size_t)((blk * 2 + (m == 0 ? 0 : 1)) * 4) * DFF + j0;
                        *(f32x4*)(eb) = pa_; *(f32x4*)(eb + DFF) = pb_; *(f32x4*)(eb + 2 * DFF) = acc[ai][0][m][n]; *(f32x4*)(eb + 3 * DFF) = acc[ai][1][m][n];
                    }
                }
            }
            __builtin_amdgcn_sched_barrier(0);
        }
    }
};
struct EpiMerge {
    static constexpr bool PERM = true;
    bf16_t* O; const bf16_t* Z;
    float* PARTM;
    __device__ __forceinline__ bool zero_after(const Unit& u) const { return u.seg == 3 || u.ks >= 0; }
    __device__ __forceinline__ void operator()(f32x4 (&acc)[2][2][4][2], const Unit& u, int wr, int wc, int fr, int fq) const {
        const bool indep = u.ks >= 0;
        if (u.seg == 2 && !indep) return;
        const int row0 = u.pm * BM + wr * 64 + fr, col0 = u.pn * BM + wc * 32 + 8 * fq;
        const bool plain = indep || u.seg == 3;
        const int sn = plain ? (u.seg < 2 ? u.seg : 2) : u.seg, sd = plain ? sn : u.seg + 1;
        const float dmask = plain ? 0.f : 1.f;
        const bf16_t* zn = Z + (size_t)row0 * IN_DIM + OFF_GATE + sn * DM + col0;
        const bf16_t* zd = Z + (size_t)row0 * IN_DIM + OFF_GATE + sd * DM + col0;
#define RAT(N, Dn) ((1.f + dmask * __expf(-(Dn))) * __builtin_amdgcn_rcpf(1.f + __expf(-(N))))
        u32x4 gn[2][2][2], gd[2][2][2];
#define MG_LOAD(B, S) do { _Pragma("unroll") for (int mm = 0; mm < 2; ++mm) _Pragma("unroll") for (int bj = 0; bj < 2; ++bj) { \
            const size_t o = (size_t)(((B) >> 1) * HALF + (((B) & 1) * 2 + mm) * 16) * IN_DIM + bj * HALF; \
            gn[S][mm][bj] = *(const u32x4*)(zn + o); gd[S][mm][bj] = *(const u32x4*)(zd + o); } } while (0)
#define MG_APPLY(B, S) do { _Pragma("unroll") for (int mm = 0; mm < 2; ++mm) _Pragma("unroll") for (int bj = 0; bj < 2; ++bj) { \
            f32x4& v0 = acc[(B) >> 1][bj][((B) & 1) * 2 + mm][0]; f32x4& v1 = acc[(B) >> 1][bj][((B) & 1) * 2 + mm][1]; \
            const u32x4 n_ = gn[S][mm][bj], d_ = gd[S][mm][bj]; \
            v0[0] *= RAT(lo_f(n_.x), lo_f(d_.x)); v0[1] *= RAT(hi_f(n_.x), hi_f(d_.x)); v0[2] *= RAT(lo_f(n_.y), lo_f(d_.y)); v0[3] *= RAT(hi_f(n_.y), hi_f(d_.y)); \
            v1[0] *= RAT(lo_f(n_.z), lo_f(d_.z)); v1[1] *= RAT(hi_f(n_.z), hi_f(d_.z)); v1[2] *= RAT(lo_f(n_.w), lo_f(d_.w)); v1[3] *= RAT(hi_f(n_.w), hi_f(d_.w)); } } while (0)
        MG_LOAD(0, 0); MG_LOAD(1, 1); __builtin_amdgcn_sched_barrier(0);
        MG_APPLY(0, 0); __builtin_amdgcn_sched_barrier(0);
        MG_LOAD(2, 0); __builtin_amdgcn_sched_barrier(0);
        MG_APPLY(1, 1); __builtin_amdgcn_sched_barrier(0);
        MG_LOAD(3, 1); __builtin_amdgcn_sched_barrier(0);
        MG_APPLY(2, 0); __builtin_amdgcn_sched_barrier(0);
        MG_APPLY(3, 1); __builtin_amdgcn_sched_barrier(0);
#undef MG_LOAD
#undef MG_APPLY
#undef RAT
        if (indep) {
            float* pb = PARTM + ((size_t)u.seg * TC + (size_t)(row0 - TL)) * DM + col0;
#pragma unroll
            for (int ai = 0; ai < 2; ++ai)
#pragma unroll
                for (int m = 0; m < 4; ++m)
#pragma unroll
                    for (int bj = 0; bj < 2; ++bj) { float* q = pb + (size_t)(ai * HALF + m * 16) * DM + bj * HALF; *(f32x4*)q = acc[ai][bj][m][0]; *(f32x4*)(q + 4) = acc[ai][bj][m][1]; }
        } else if (u.seg == 3) {
            bf16_t* ob = O + (size_t)row0 * DM + col0;
#pragma unroll
            for (int ai = 0; ai < 2; ++ai)
#pragma unroll
                for (int m = 0; m < 4; ++m)
#pragma unroll
                    for (int bj = 0; bj < 2; ++bj) { const f32x4 v0 = acc[ai][bj][m][0], v1 = acc[ai][bj][m][1];
                        u32x4 w; w.x = cvt_pk_bf16(v0[0], v0[1]); w.y = cvt_pk_bf16(v0[2], v0[3]); w.z = cvt_pk_bf16(v1[0], v1[1]); w.w = cvt_pk_bf16(v1[2], v1[3]);
                        *(u32x4*)(ob + (size_t)(ai * HALF + m * 16) * DM + bj * HALF) = w; }
        }
    }
};

#ifndef PG8_SP2
#define PG8_SP2 true
#endif
#ifndef PG8_ALIGN
#define PG8_ALIGN true
#endif
template <class Epi, bool ALIGN_EPI = PG8_ALIGN, bool SP2 = PG8_SP2>
__device__ __forceinline__ void gemm_phase(LAS unsigned char* lds, const int tid, const int K, const Order& S, const Epi& E) {
    const int wid = __builtin_amdgcn_readfirstlane(tid >> 6), lane = tid & 63, wr = wid >> 2, wc = wid & 3, fr = lane & 15, fq = lane >> 4;
    unsigned voffA[2], voffB[2];
#pragma unroll
    for (int i = 0; i < 2; ++i) { int R, C; stage_rc(tid * 16 + i * 8192, R, C); const int Rb = Epi::PERM ? ((R & ~31) + perm32(R & 31)) : R;
        voffA[i] = (unsigned)(R * K + C) * 2u; voffB[i] = (unsigned)(Rb * K + C) * 2u; }
    const size_t kstep = (size_t)(BK * 2);
    const size_t hstep = (size_t)HALF * K * 2;
    const unsigned ldsw = (unsigned)wid * 1024u;
    const int aoff = lds_byte(wr * 64 + fr, fq * 8), boff = lds_byte(wc * 32 + fr, fq * 8);
#define PG8_SA(b, h) (((b) * 2 + (h)) * HTB)
#define PG8_SB(b, h) ((4 + (b) * 2 + (h)) * HTB)
#define PG8_STAGE(bufoff, gbase, voff) do { _Pragma("unroll") for (int _i = 0; _i < 2; ++_i) \
        __builtin_amdgcn_global_load_lds((const unsigned*)((const char*)(gbase) + (voff)[_i]), (LAS unsigned*)(lds + (bufoff) + ldsw + _i * 8192), 16, 0, 0); } while (0)
#define PG8_LDA(dst, b, h) do { _Pragma("unroll") for (int m = 0; m < 4; ++m) _Pragma("unroll") for (int k = 0; k < 2; ++k) dst[m][k] = *(const LAS bf16x8*)(lds + PG8_SA(b, h) + aoff + m * 2048 + k * 1024); } while (0)
#define PG8_LDB(dst, b, h) do { _Pragma("unroll") for (int n = 0; n < 2; ++n) _Pragma("unroll") for (int k = 0; k < 2; ++k) dst[n][k] = *(const LAS bf16x8*)(lds + PG8_SB(b, h) + boff + n * 2048 + k * 1024); } while (0)
#define PG8_MMA(ai, bj, At, Bt) do { __builtin_amdgcn_s_setprio(1); _Pragma("unroll") for (int m = 0; m < 4; ++m) _Pragma("unroll") for (int n = 0; n < 2; ++n) _Pragma("unroll") for (int k = 0; k < 2; ++k) \
        acc[ai][bj][m][n] = __builtin_amdgcn_mfma_f32_16x16x32_bf16(Bt[n][k], At[m][k], acc[ai][bj][m][n], 0, 0, 0); __builtin_amdgcn_s_setprio(0); } while (0)
#define PG8_WAIT_V(n) asm volatile("s_waitcnt vmcnt(" #n ")" ::: "memory")
#define PG8_WAIT_L(n) asm volatile("s_waitcnt lgkmcnt(" #n ")" ::: "memory")
#define PG8_BAR __builtin_amdgcn_s_barrier()
#define PG8_SCHED __builtin_amdgcn_sched_barrier(0)
    Unit cur, nxt; int ui = 0;
    if (!S.next(0, cur)) return;
    f32x4 acc[2][2][4][2];
#pragma unroll
    for (int a = 0; a < 2; ++a)
#pragma unroll
        for (int b = 0; b < 2; ++b)
#pragma unroll
            for (int m = 0; m < 4; ++m)
#pragma unroll
                for (int n = 0; n < 2; ++n) acc[a][b][m][n] = (f32x4){0.f, 0.f, 0.f, 0.f};
    bf16x8 At[4][2], B0[2][2], B1[2][2];
    const char* cA = S.aptr(cur); const char* cB = S.bptr(cur);
    if constexpr (SP2) {
        PG8_STAGE(PG8_SB(0, 0), cB, voffB); PG8_STAGE(PG8_SB(0, 1), cB + hstep, voffB); PG8_STAGE(PG8_SA(0, 0), cA, voffA); PG8_STAGE(PG8_SA(0, 1), cA + hstep, voffA);
        if (wr == 1) PG8_BAR;
        PG8_WAIT_V(2); PG8_BAR;
        PG8_STAGE(PG8_SB(1, 0), cB + kstep, voffB); PG8_STAGE(PG8_SA(1, 0), cA + kstep, voffA); PG8_STAGE(PG8_SB(1, 1), cB + hstep + kstep, voffB);
        PG8_WAIT_V(6); PG8_BAR;
    } else {
    PG8_STAGE(PG8_SB(0, 0), cB, voffB); PG8_STAGE(PG8_SA(0, 0), cA, voffA); PG8_STAGE(PG8_SB(0, 1), cB + hstep, voffB); PG8_STAGE(PG8_SA(0, 1), cA + hstep, voffA);
    if (wr == 1) PG8_BAR;
    PG8_WAIT_V(4); PG8_BAR;
    PG8_STAGE(PG8_SB(1, 0), cB + kstep, voffB); PG8_STAGE(PG8_SA(1, 0), cA + kstep, voffA); PG8_STAGE(PG8_SB(1, 1), cB + hstep + kstep, voffB);
    PG8_WAIT_V(6); PG8_BAR;
    }
    for (;;) {
        const bool has_next = S.next(ui + 1, nxt);
        const char* nA = has_next ? S.aptr(nxt) : cA; const char* nB = has_next ? S.bptr(nxt) : cB;
        const int nt = S.nt(cur);
        for (int t = 0; t < nt; t += 2) {
            const bool last = (t == nt - 2);
            const char* a1 = cA + (size_t)(t + 1) * kstep;
            const char* a2 = last ? nA : cA + (size_t)(t + 2) * kstep; const char* b2 = last ? nB : cB + (size_t)(t + 2) * kstep;
            const char* a3 = a2 + kstep; const char* b3 = b2 + kstep;
            if (last && has_next) S.a_ready(nxt, tid);
            if constexpr (SP2) {
            PG8_LDB(B0, 0, 0); PG8_LDB(B1, 0, 1); PG8_SCHED; PG8_LDA(At, 0, 0); PG8_STAGE(PG8_SA(1, 1), a1 + hstep, voffA);
            PG8_WAIT_V(8); PG8_WAIT_L(0); PG8_BAR; PG8_MMA(0, 0, At, B0); PG8_MMA(0, 1, At, B1); PG8_BAR; PG8_SCHED;
            PG8_LDA(At, 0, 1); PG8_STAGE(PG8_SB(0, 0), b2, voffB); PG8_STAGE(PG8_SB(0, 1), b2 + hstep, voffB); PG8_STAGE(PG8_SA(0, 0), a2, voffA);
            PG8_WAIT_V(8); PG8_WAIT_L(0); PG8_BAR; PG8_MMA(1, 0, At, B0); PG8_MMA(1, 1, At, B1); PG8_BAR; PG8_SCHED;
            PG8_LDB(B0, 1, 0); PG8_LDB(B1, 1, 1); PG8_SCHED; PG8_LDA(At, 1, 0); PG8_STAGE(PG8_SA(0, 1), a2 + hstep, voffA);
            PG8_WAIT_V(8); PG8_WAIT_L(0); PG8_BAR; PG8_MMA(0, 0, At, B0); PG8_MMA(0, 1, At, B1); PG8_BAR; PG8_SCHED;
            PG8_LDA(At, 1, 1); PG8_STAGE(PG8_SB(1, 0), b3, voffB); PG8_STAGE(PG8_SB(1, 1), b3 + hstep, voffB); PG8_STAGE(PG8_SA(1, 0), a3, voffA);
            PG8_WAIT_V(8); PG8_WAIT_L(0); PG8_BAR; PG8_MMA(1, 0, At, B0); PG8_MMA(1, 1, At, B1); PG8_BAR; PG8_SCHED;
            } else {
            PG8_LDB(B0, 0, 0); PG8_SCHED; PG8_LDA(At, 0, 0); PG8_STAGE(PG8_SA(1, 1), a1 + hstep, voffA);
            PG8_WAIT_L(8); PG8_BAR; PG8_WAIT_L(0); PG8_MMA(0, 0, At, B0); PG8_BAR; PG8_SCHED;
            PG8_LDB(B1, 0, 1); PG8_STAGE(PG8_SB(0, 0), b2, voffB);
            PG8_BAR; PG8_WAIT_L(0); PG8_MMA(0, 1, At, B1); PG8_BAR;
            PG8_LDA(At, 0, 1); PG8_STAGE(PG8_SA(0, 0), a2, voffA);
            PG8_BAR; PG8_WAIT_L(0); PG8_MMA(1, 0, At, B0); PG8_BAR; PG8_SCHED;
            PG8_STAGE(PG8_SB(0, 1), b2 + hstep, voffB);
            PG8_WAIT_V(6); PG8_BAR; PG8_MMA(1, 1, At, B1); PG8_BAR;
            PG8_LDB(B0, 1, 0); PG8_SCHED; PG8_LDA(At, 1, 0); PG8_STAGE(PG8_SA(0, 1), a2 + hstep, voffA);
            PG8_WAIT_L(8); PG8_BAR; PG8_WAIT_L(0); PG8_MMA(0, 0, At, B0); PG8_BAR; PG8_SCHED;
            PG8_LDB(B1, 1, 1); PG8_STAGE(PG8_SB(1, 0), b3, voffB);
            PG8_BAR; PG8_WAIT_L(0); PG8_MMA(0, 1, At, B1); PG8_BAR;
            PG8_LDA(At, 1, 1); PG8_STAGE(PG8_SA(1, 0), a3, voffA);
            PG8_BAR; PG8_WAIT_L(0); PG8_MMA(1, 0, At, B0); PG8_BAR; PG8_SCHED;
            PG8_STAGE(PG8_SB(1, 1), b3 + hstep, voffB);
            PG8_WAIT_V(6); PG8_BAR; PG8_MMA(1, 1, At, B1); PG8_BAR;
            }
        }
        if constexpr (ALIGN_EPI) { if (wr == 0) PG8_BAR; }
        E(acc, cur, wr, wc, fr, fq);
        if (!has_next) break;
        if (E.zero_after(cur)) {
#pragma unroll
            for (int a = 0; a < 2; ++a)
#pragma unroll
                for (int b = 0; b < 2; ++b)
#pragma unroll
                    for (int m = 0; m < 4; ++m)
#pragma unroll
                        for (int n = 0; n < 2; ++n) acc[a][b][m][n] = (f32x4){0.f, 0.f, 0.f, 0.f};
        }
        cur = nxt; cA = nA; cB = nB; ++ui;
        if constexpr (ALIGN_EPI) { if (wr == 1) PG8_BAR; }
    }
    PG8_WAIT_V(0);
    if constexpr (!ALIGN_EPI) { if (wr == 0) PG8_BAR; }
    PG8_BAR;
#undef PG8_SA
#undef PG8_SB
#undef PG8_STAGE
#undef PG8_LDA
#undef PG8_LDB
#undef PG8_MMA
#undef PG8_WAIT_V
#undef PG8_WAIT_L
#undef PG8_BAR
#undef PG8_SCHED
}
}

#ifndef ATT_SDEPTH
#define ATT_SDEPTH 2
#endif
namespace att {
constexpr int D = 128, NW = 8, QBLK = 32, KVBLK = 64;
constexpr float SCALE = 0.088388347648318440f;
constexpr float THR = 8.f;
constexpr int LDQ = 2048, LDK = 512, LDO = 1024;
constexpr size_t SHM_V = KVBLK * D * 2, SHM_K = KVBLK * D * 2, SHM_ATTN = 2 * SHM_V + 2 * SHM_K + NW * 64 * 4;
#define KSWZ(row, colB) ((row) * 256 + ((colB) ^ (((row) & 7) << 4)))
#define SBAR() __builtin_amdgcn_sched_barrier(0)
__device__ __forceinline__ int crow(int r, int hi) { return (r & 3) + 8 * (r >> 2) + 4 * hi; }
__device__ __forceinline__ unsigned cvtpk(float lo, float hi) { unsigned r; asm volatile("v_cvt_pk_bf16_f32 %0, %1, %2" : "=v"(r) : "v"(lo), "v"(hi)); return r; }
__device__ __forceinline__ bf16x8 ld8(const bf16_t* p) { return *reinterpret_cast<const bf16x8*>(p); }

__device__ __forceinline__ void partialSM(f32x16& p0, f32x16& p1, float& m_reg, float& mn, float& alpha) {
  constexpr float C = SCALE * 1.4426950408889634f;
  float pmax = p0[0];
#pragma unroll
  for (int r = 1; r < 16; ++r) pmax = fmaxf(pmax, p0[r]);
#pragma unroll
  for (int r = 0; r < 16; ++r) pmax = fmaxf(pmax, p1[r]);
  { auto rr = __builtin_amdgcn_permlane32_swap(__float_as_uint(pmax), __float_as_uint(pmax), false, false);
    pmax = fmaxf(__uint_as_float(rr[0]), __uint_as_float(rr[1])); }
  if (__builtin_expect(__all(pmax - m_reg <= THR / SCALE), 1)) { mn = m_reg; alpha = 1.f; }
  else { mn = fmaxf(m_reg, pmax); alpha = __builtin_amdgcn_exp2f((m_reg - mn) * C); m_reg = mn; }
  float mnC = -mn * C;
#pragma unroll
  for (int r = 0; r < 16; ++r) p0[r] = fmaf(p0[r], C, mnC);
#pragma unroll
  for (int r = 0; r < 16; ++r) p1[r] = fmaf(p1[r], C, mnC);
#pragma unroll
  for (int r = 0; r < 16; ++r) p0[r] = __builtin_amdgcn_exp2f(p0[r]);
}
__device__ __forceinline__ void finishSM(f32x16& p0, f32x16& p1, float alpha, float& l_reg, bf16x8& pa0, bf16x8& pa1, bf16x8& pa2, bf16x8& pa3) {
#pragma unroll
  for (int r = 0; r < 16; ++r) p1[r] = __builtin_amdgcn_exp2f(p1[r]);
  float ps = 0;
#pragma unroll
  for (int r = 0; r < 16; ++r) ps += p0[r];
#pragma unroll
  for (int r = 0; r < 16; ++r) ps += p1[r];
  { auto rr = __builtin_amdgcn_permlane32_swap(__float_as_uint(ps), __float_as_uint(ps), false, false);
    ps = __uint_as_float(rr[0]) + __uint_as_float(rr[1]); }
  l_reg = l_reg * alpha + ps;
#define PK4(P, BASE, OUT) do { unsigned a0 = cvtpk(P[BASE + 0], P[BASE + 1]), a1 = cvtpk(P[BASE + 2], P[BASE + 3]);   \
    unsigned b0 = cvtpk(P[BASE + 4], P[BASE + 5]), b1 = cvtpk(P[BASE + 6], P[BASE + 7]);                              \
    auto r0 = __builtin_amdgcn_permlane32_swap(a0, b0, false, false); auto r1 = __builtin_amdgcn_permlane32_swap(a1, b1, false, false); \
    u32x4 w = {r0[0], r1[0], r0[1], r1[1]}; OUT = *reinterpret_cast<bf16x8*>(&w); } while (0)
  PK4(p0, 0, pa0); PK4(p0, 8, pa1); PK4(p1, 0, pa2); PK4(p1, 8, pa3);
#undef PK4
}
__device__ __forceinline__ void qkt(f32x16& p0, f32x16& p1, const bf16_t* Ks, const bf16x8* qr, int r32, int hi) {
  p0 = f32x16{}; p1 = f32x16{};
#pragma unroll
  for (int d0 = 0; d0 < 8; ++d0) { int cb = (d0 * 16 + hi * 8) * 2;
    bf16x8 b0 = *reinterpret_cast<const bf16x8*>((const char*)Ks + KSWZ(r32, cb));
    bf16x8 b1 = *reinterpret_cast<const bf16x8*>((const char*)Ks + KSWZ(32 + r32, cb));
    p0 = __builtin_amdgcn_mfma_f32_32x32x16_bf16(b0, qr[d0], p0, 0, 0, 0);
    p1 = __builtin_amdgcn_mfma_f32_32x32x16_bf16(b1, qr[d0], p1, 0, 0, 0); }
}
__device__ __forceinline__ int v_st(int k, int c) { const int kk = (k & ~0xC) | ((k & 4) << 1) | ((k & 8) >> 1); return ((kk >> 3) * 4 + (c >> 5)) * 512 + ((kk & 7) * 32 + (c & 31)) * 2; }
__device__ __forceinline__ int v_rd_base(int lane) { return ((lane & 3) << 3) | (((lane >> 2) & 3) << 6) | (((lane >> 4) & 1) << 5) | (((lane >> 5) & 1) << 8); }
constexpr int v_rd_off(int d0, int ks, int half) { return d0 * 512 + ks * 4096 + half * 2048; }
template <int OFF> __device__ __forceinline__ s16x4 tr_read(int vb) {
  s16x4 r; asm volatile("ds_read_b64_tr_b16 %0, %1 offset:%2" : "=&v"(r) : "v"(vb), "i"(OFF) : "memory"); return r;
}
template <int D0> __device__ __forceinline__ void pv_one(f32x16& od, int vb, bf16x8 pa0, bf16x8 pa1, bf16x8 pa2, bf16x8 pa3) {
  const s16x4 l0 = tr_read<v_rd_off(D0, 0, 0)>(vb), h0 = tr_read<v_rd_off(D0, 0, 1)>(vb), l1 = tr_read<v_rd_off(D0, 1, 0)>(vb), h1 = tr_read<v_rd_off(D0, 1, 1)>(vb);
  const s16x4 l2 = tr_read<v_rd_off(D0, 2, 0)>(vb), h2 = tr_read<v_rd_off(D0, 2, 1)>(vb), l3 = tr_read<v_rd_off(D0, 3, 0)>(vb), h3 = tr_read<v_rd_off(D0, 3, 1)>(vb);
  asm volatile("s_waitcnt lgkmcnt(0)" ::: "memory"); SBAR();
#define PK(L, H) (bf16x8){L[0], L[1], L[2], L[3], H[0], H[1], H[2], H[3]}
  od = __builtin_amdgcn_mfma_f32_32x32x16_bf16(pa0, PK(l0, h0), od, 0, 0, 0);
  od = __builtin_amdgcn_mfma_f32_32x32x16_bf16(pa1, PK(l1, h1), od, 0, 0, 0);
  od = __builtin_amdgcn_mfma_f32_32x32x16_bf16(pa2, PK(l2, h2), od, 0, 0, 0);
  od = __builtin_amdgcn_mfma_f32_32x32x16_bf16(pa3, PK(l3, h3), od, 0, 0, 0);
#undef PK
}
__device__ __forceinline__ void pv_d0(f32x16* o, int vb, bf16x8 pa0, bf16x8 pa1, bf16x8 pa2, bf16x8 pa3) {
  pv_one<0>(o[0], vb, pa0, pa1, pa2, pa3); pv_one<1>(o[1], vb, pa0, pa1, pa2, pa3); pv_one<2>(o[2], vb, pa0, pa1, pa2, pa3); pv_one<3>(o[3], vb, pa0, pa1, pa2, pa3);
}

__device__ __forceinline__ void attn_dense_body(const bf16_t* __restrict__ Qb, const bf16_t* __restrict__ Kh, const bf16_t* __restrict__ Vh,
                                                bf16_t* __restrict__ Ob, int seq, char* lds, const int tid) {
  constexpr int SDEPTH = ATT_SDEPTH;
  const int wid = tid >> 6, lane = tid & 63, r32 = lane & 31, hi = lane >> 5;
  bf16_t* V_lds = (bf16_t*)lds; bf16_t* K_lds = (bf16_t*)(lds + 2 * SHM_V);
  float* ws = (float*)(lds + 2 * SHM_V + 2 * SHM_K) + wid * 64; float* li_l = ws; float* al_l = ws + 32;
  float m_reg = -1e30f, l_reg = 0; f32x16 o[4] = {}; bf16x8 qr[8];
  const bf16_t* Qw = Qb + (long)(wid * QBLK + r32) * LDQ + hi * 8;
#pragma unroll
  for (int d0 = 0; d0 < 8; ++d0) qr[d0] = ld8(Qw + d0 * 16);
  const int sr = tid >> 4, sc = (tid & 15) * 8, vst0 = v_st(sr, sc), vst1 = v_st(32 + sr, sc);
  const int vb0 = (int)(uintptr_t)V_lds + v_rd_base(lane);
  struct { bf16x8 vs0, vs1, ks0, ks1; } sr_[SDEPTH];
  const unsigned so0 = (unsigned)(sr * LDK + sc) * 2u, so1 = so0 + 32u * LDK * 2u;
#define SLOAD(i, k0) do { const char* vb_ = (const char*)Vh + (size_t)(k0) * (LDK * 2); const char* kb_ = (const char*)Kh + (size_t)(k0) * (LDK * 2); \
    sr_[i].vs0 = *reinterpret_cast<const bf16x8*>(vb_ + so0); sr_[i].vs1 = *reinterpret_cast<const bf16x8*>(vb_ + so1); \
    sr_[i].ks0 = *reinterpret_cast<const bf16x8*>(kb_ + so0); sr_[i].ks1 = *reinterpret_cast<const bf16x8*>(kb_ + so1); } while (0)
#define SWRITE(b, i) do { *(bf16x8*)((char*)V_lds + (b) * SHM_V + vst0) = sr_[i].vs0;          \
    *(bf16x8*)((char*)V_lds + (b) * SHM_V + vst1) = sr_[i].vs1; int kc = sc * 2;               \
    *(bf16x8*)((char*)K_lds + (b) * SHM_K + KSWZ(sr, kc)) = sr_[i].ks0;                       \
    *(bf16x8*)((char*)K_lds + (b) * SHM_K + KSWZ(32 + sr, kc)) = sr_[i].ks1; } while (0)
#define SWAIT() do { if constexpr (SDEPTH == 2) asm volatile("s_waitcnt vmcnt(4)" ::: "memory"); else asm volatile("s_waitcnt vmcnt(0)" ::: "memory"); } while (0)
#define RESC(a) do { if (__any((a) < 1.f)) { if (hi == 0) al_l[r32] = (a); asm volatile("s_waitcnt lgkmcnt(0)" ::: "memory"); \
    _Pragma("unroll") for (int d = 0; d < 4; ++d) _Pragma("unroll") for (int r = 0; r < 16; ++r) o[d][r] *= al_l[crow(r, hi)]; } } while (0)
  f32x16 pA0, pA1, pB0, pB1; float mnA, mnB, alA, alB; bf16x8 pa0, pa1, pa2, pa3; const int NT = seq / KVBLK;
  constexpr int SE = 0, SO = SDEPTH - 1;
  SLOAD(SE, 0); asm volatile("s_waitcnt vmcnt(0)" ::: "memory"); SWRITE(0, SE); __syncthreads();
  qkt(pA0, pA1, K_lds, qr, r32, hi); partialSM(pA0, pA1, m_reg, mnA, alA);
  SLOAD(SO, KVBLK); if constexpr (SDEPTH == 2) { if (2 < NT) SLOAD(SE, 2 * KVBLK); }
  SWAIT(); SWRITE(1, SO); __syncthreads();
  for (int j = 1; j + 1 < NT; j += 2) {
    SBAR(); qkt(pB0, pB1, (bf16_t*)((char*)K_lds + SHM_K), qr, r32, hi);
    finishSM(pA0, pA1, alA, l_reg, pa0, pa1, pa2, pa3); SBAR();
    SLOAD(SO, (j + SDEPTH) * KVBLK); SBAR();
    pv_d0(o, vb0, pa0, pa1, pa2, pa3); partialSM(pB0, pB1, m_reg, mnB, alB);
    __syncthreads(); SWAIT(); SWRITE(0, SE);
    RESC(alB); __syncthreads();
    SBAR(); qkt(pA0, pA1, K_lds, qr, r32, hi);
    finishSM(pB0, pB1, alB, l_reg, pa0, pa1, pa2, pa3); SBAR();
    if (SDEPTH == 1 || j + 3 < NT) SLOAD(SE, (j + 1 + SDEPTH) * KVBLK); SBAR();
    pv_d0(o, vb0 + (int)SHM_V, pa0, pa1, pa2, pa3); partialSM(pA0, pA1, m_reg, mnA, alA);
    __syncthreads(); SWAIT(); SWRITE(1, SO);
    RESC(alA); __syncthreads();
  }
  SBAR(); qkt(pB0, pB1, (bf16_t*)((char*)K_lds + SHM_K), qr, r32, hi);
  finishSM(pA0, pA1, alA, l_reg, pa0, pa1, pa2, pa3); SBAR();
  pv_d0(o, vb0, pa0, pa1, pa2, pa3); partialSM(pB0, pB1, m_reg, mnB, alB);
  __syncthreads(); RESC(alB);
  finishSM(pB0, pB1, alB, l_reg, pa0, pa1, pa2, pa3); SBAR();
  pv_d0(o, vb0 + (int)SHM_V, pa0, pa1, pa2, pa3);
  if (hi == 0) li_l[r32] = l_reg; asm volatile("s_waitcnt lgkmcnt(0)" ::: "memory");
  float rli[16];
#pragma unroll
  for (int r = 0; r < 16; ++r) rli[r] = __builtin_amdgcn_rcpf(li_l[crow(r, hi)]);
  bf16_t* Ow = Ob + (long)(wid * QBLK) * LDO;
#pragma unroll
  for (int r = 0; r < 16; ++r) { int orow = crow(r, hi);
#pragma unroll
    for (int d0 = 0; d0 < 4; ++d0) Ow[(long)orow * LDO + d0 * 32 + r32] = f2bf(o[d0][r] * rli[r]); }
  __syncthreads();
#undef SLOAD
#undef SWRITE
#undef SWAIT
#undef RESC
}
}

#define XB_TMO      128
#define XB_XCNT(j)  (256  + 64 * (j))
#define XB_XSUB(j)  (1280 + 64 * (j))
#define XB_XGEN(j)  (2304 + 64 * (j))
#define XB_TOP      3328
#define XB_TOPGEN   3392
#define XCD_BAR_WORDS 3456
#define XB_SPIN_CAP (1u << 20)
__device__ __forceinline__ unsigned xb_ld(unsigned* p)              { return __hip_atomic_load(p, __ATOMIC_RELAXED, __HIP_MEMORY_SCOPE_AGENT); }
__device__ __forceinline__ unsigned xb_add(unsigned* p, unsigned v) { return __hip_atomic_fetch_add(p, v, __ATOMIC_RELAXED, __HIP_MEMORY_SCOPE_AGENT); }
__device__ __forceinline__ unsigned xb_xcc_id() { return (unsigned)__builtin_amdgcn_s_getreg((3 << 11) | 20) & 0xFu; }
#define XB_SPIN(cond, bar) do { unsigned _sp = 0; while (cond) { __builtin_amdgcn_s_sleep(1); \
    if ((++_sp & 255u) == 0u) { if (xb_ld(&(bar)[XB_TMO])) break; if (_sp > XB_SPIN_CAP) { atomicAdd(&(bar)[XB_TMO], 1u); break; } } } } while (0)
struct XcdBarrier { unsigned* bar; unsigned x; volatile LAS unsigned* st; int wave_s; };
__device__ __forceinline__ int lane_id_() { return (int)__builtin_amdgcn_mbcnt_hi(~0u, __builtin_amdgcn_mbcnt_lo(~0u, 0u)); }
__device__ __forceinline__ XcdBarrier xcd_barrier_post(unsigned* bar, volatile LAS unsigned* st, int wave_s) {
    XcdBarrier b; b.bar = bar; b.x = xb_xcc_id(); b.st = st; b.wave_s = wave_s;
    if (wave_s == 0 && lane_id_() == 0) (void)xb_add(&bar[XB_XCNT(b.x)], 1u);
    return b;
}
__device__ __forceinline__ void xcd_barrier_complete(unsigned* bar, unsigned x, unsigned& nloc, unsigned& nx) {
    const unsigned G = gridDim.x * gridDim.y * gridDim.z;
    unsigned sum, cnt, mine, sp = 0u;
    for (;;) {
        sum = 0u; cnt = 0u; mine = 0u;
#pragma unroll
        for (unsigned j = 0; j < 16; ++j) { const unsigned c = xb_ld(&bar[XB_XCNT(j)]); sum += c; cnt += (c > 0u) ? 1u : 0u; mine = (j == x) ? c : mine; }
        if (sum == G) break;
        __builtin_amdgcn_s_sleep(1);
        if ((++sp & 255u) == 0u) { if (xb_ld(&bar[XB_TMO])) break; if (sp > XB_SPIN_CAP) { atomicAdd(&bar[XB_TMO], 1u); break; } }
    }
    nloc = mine > 0u ? mine : 1u; nx = cnt > 0u ? cnt : 1u;
}
__device__ __forceinline__ void xcd_barrier(const XcdBarrier& b) {
    asm volatile("s_waitcnt vmcnt(0)" ::: "memory");
    __syncthreads();
    if (b.wave_s == 0 && lane_id_() == 0) {
        unsigned* bar = b.bar; asm volatile("" : "+s"(bar));
        __builtin_amdgcn_s_waitcnt(0);
        unsigned nloc = b.st[0], nx = b.st[1];
        if (nloc == 0u) { xcd_barrier_complete(bar, b.x, nloc, nx); b.st[0] = nloc; b.st[1] = nx; }
        const unsigned old = xb_add(&bar[XB_XSUB(b.x)], 1u);
        const unsigned gen = old / nloc;
        if (old + 1u == (gen + 1u) * nloc) {
            __builtin_amdgcn_fence(__ATOMIC_RELEASE, "agent");
            asm volatile("s_waitcnt vmcnt(0)" ::: "memory");
            const unsigned og = xb_add(&bar[XB_TOP], 1u);
            const unsigned tg = og / nx;
            if (og + 1u == (tg + 1u) * nx) xb_add(&bar[XB_TOPGEN], 1u);
            else XB_SPIN(xb_ld(&bar[XB_TOPGEN]) == tg, bar);
            __builtin_amdgcn_fence(__ATOMIC_ACQUIRE, "agent");
            xb_add(&bar[XB_XGEN(b.x)], 1u);
            asm volatile("s_waitcnt vmcnt(0)" ::: "memory");
        } else {
            XB_SPIN(xb_ld(&bar[XB_XGEN(b.x)]) == gen, bar);
            __builtin_amdgcn_fence(__ATOMIC_ACQUIRE, "agent");
            asm volatile("s_waitcnt vmcnt(0)" ::: "memory");
        }
    }
    __syncthreads();
}

typedef const __attribute__((address_space(4))) Params* KParams;
struct Ctx {
    KParams p; unsigned char* ws; int bid, G, tid, lane, wave;
    __device__ __forceinline__ bf16_t* bfp(size_t off) const { return (bf16_t*)(ws + off); }
    __device__ __forceinline__ float* fp(size_t off) const { return (float*)(ws + off); }
};

struct TTile { f32x4 v[4]; };
struct TRes { const float* src; bf16_t* dst; int N, ldt; };
__device__ __forceinline__ void ttile_load(TTile& T, const TRes& R, const int tid) {
    const int r = tid >> 4, c4 = tid & 15;
#pragma unroll
    for (int ps = 0; ps < 4; ++ps) T.v[ps] = __builtin_nontemporal_load((const f32x4*)(R.src + (size_t)(r + 32 * ps) * R.N + c4 * 4));
}
__device__ __forceinline__ void ttile_emit(const TTile& T, const TRes& R, float* tile, const int tid) {
    const int r = tid >> 4, c4 = tid & 15;
#pragma unroll
    for (int ps = 0; ps < 4; ++ps) { float* t = tile + (r + 32 * ps) * 65 + c4 * 4; t[0] = T.v[ps][0]; t[1] = T.v[ps][1]; t[2] = T.v[ps][2]; t[3] = T.v[ps][3]; }
    __syncthreads();
    const int kg = tid & 15, nn = tid >> 4;
#pragma unroll
    for (int ps = 0; ps < 2; ++ps) { const int n = nn + 32 * ps; const float* t = tile + (kg * 8) * 65 + n;
        u32x4 w; w.x = cvt_pk_bf16(t[0], t[65]); w.y = cvt_pk_bf16(t[130], t[195]); w.z = cvt_pk_bf16(t[260], t[325]); w.w = cvt_pk_bf16(t[390], t[455]);
        *(u32x4*)(R.dst + (size_t)n * R.ldt + kg * 8) = w; }
    __syncthreads();
}
constexpr int WT_TILES = 3584 + 4 * 256 + 512 + 2752 + 1376;
__device__ __forceinline__ TRes tresolve(const Ctx& c, int l, int g) {
    const KParams pk = c.p;
    const float* src; bf16_t* dst; int N, ldt, t = g; bool isup = false;
    if (t < 3584) { src = pk->in[7] + (size_t)l * DM * IN_DIM; N = IN_DIM; ldt = DM; dst = c.bfp(WS_WIN + l * SZ_WIN); }
    else if ((t -= 3584) < 1024) { const int w = t >> 8; t &= 255; N = DM; ldt = 1024; dst = c.bfp(WS_WM + l * SZ_WM + (size_t)w * (SZ_WM / 4));
        src = w == 0 ? pk->in[14] + (size_t)l * 1024 * DM : w == 1 ? pk->in[15] + (size_t)l * 1024 * DM : pk->in[16] + (size_t)l * DM * DM + (size_t)(w - 2) * 1024 * DM; }
    else if ((t -= 1024) < 512) { src = pk->in[17] + (size_t)l * DM * DM; N = DM; ldt = DM; dst = c.bfp(WS_WO + l * SZ_WO); }
    else if ((t -= 512) < 2752) { src = pk->in[19] + (size_t)l * DM * DFF2; N = DFF2; ldt = DM; dst = c.bfp(WS_WUP + l * SZ_WUP); isup = true; }
    else { t -= 2752; src = pk->in[21] + (size_t)l * DFF * DM; N = DM; ldt = DFF; dst = c.bfp(WS_WDN + l * SZ_WDN); }
    const int nnt = N >> 6, kt = t / nnt, ntl = t - kt * nnt;
    int drow = ntl * 64;
    if (isup) { const int n0 = ntl * 64, bj = n0 >= DFF ? 1 : 0, jrel = n0 - bj * DFF; drow = (jrel >> 7) * 256 + bj * 128 + (jrel & 127); }
    TRes R; R.src = src + (size_t)(kt * 128) * N + ntl * 64; R.dst = dst + (size_t)drow * ldt + kt * 128; R.N = N; R.ldt = ldt; return R;
}
__device__ void weights_range(const Ctx& c, int l, int g0, int stride, int gend, int maxn, float* lds) {
    TTile T0, T1; TRes R0, R1;
    int g = g0, left = maxn;
    bool v0 = g < gend && left > 0;
    if (v0) { R0 = tresolve(c, l, g); ttile_load(T0, R0, c.tid); }
    while (v0) {
        const int g1 = g + stride, g2 = g1 + stride;
        const bool v1 = g1 < gend && left > 1, v2 = v1 && g2 < gend && left > 2;
        if (v1) { R1 = tresolve(c, l, g1); ttile_load(T1, R1, c.tid); }
        ttile_emit(T0, R0, lds, c.tid);
        if (v2) { R0 = tresolve(c, l, g2); ttile_load(T0, R0, c.tid); }
        if (v1) ttile_emit(T1, R1, lds, c.tid);
        g = g2; left -= 2; v0 = v2;
    }
}
constexpr int WTA_N = 28, WTB_N = 16, WTC_N = 25;
constexpr int WTA_END = 32 * WTA_N, WTB_END = WTA_END + 128 * WTB_N, WTC_END = WTB_END + 244 * WTC_N;
static_assert(WTC_END <= WT_TILES, "tail budgets exceed the tile list");

__device__ void phase_prep(const Ctx& c, float* lds) {
    const KParams pk = c.p;
    {
        float* s = lds; float* red = lds + 5 * DM;
        for (int i = c.tid; i < 5 * DM; i += NTHR) { const int r = i / DM, k = i % DM; const float v = r < 4 ? pk->in[1][r * DM + k] : pk->in[3][k]; s[i] = v / (1.f + __expf(-v)); }
        __syncthreads();
        const int kg = c.tid >> 5, l32 = c.tid & 31;
        for (int unit = c.bid; unit < 256; unit += c.G) {
            const int l = unit >> 7, n0 = (unit & 127) * 96;
            const float* W = pk->in[4] + (size_t)l * DM * MODW + n0 + l32;
            float a0[5] = {0.f, 0.f, 0.f, 0.f, 0.f}, a1[5] = {0.f, 0.f, 0.f, 0.f, 0.f}, a2[5] = {0.f, 0.f, 0.f, 0.f, 0.f};
            const int kb = kg * 128;
#pragma unroll 8
            for (int k = kb; k < kb + 128; ++k) { const float* wr_ = W + (size_t)k * MODW; const float w0 = wr_[0], w1 = wr_[32], w2 = wr_[64];
#pragma unroll
                for (int r = 0; r < 5; ++r) { const float sv = s[r * DM + k]; a0[r] += sv * w0; a1[r] += sv * w1; a2[r] += sv * w2; } }
#pragma unroll
            for (int r = 0; r < 5; ++r) { float* rp = red + (kg * 5 + r) * 96 + l32; rp[0] = a0[r]; rp[32] = a1[r]; rp[64] = a2[r]; }
            __syncthreads();
            for (int i = c.tid; i < 5 * 96; i += NTHR) { const int r = i / 96, ci = i - r * 96; float sum = 0.f;
#pragma unroll
                for (int w = 0; w < 16; ++w) sum += red[(w * 5 + r) * 96 + ci];
                c.fp(WS_MOD)[(size_t)(l * 5 + r) * MODW + n0 + ci] = sum + pk->in[5][l * MODW + n0 + ci]; }
            __syncthreads();
        }
    }
    for (int i = c.bid * NTHR + c.tid; i < SEQL * 64; i += c.G * NTHR) { const int t = i >> 6, ax = (i >> 5) & 1, f = i & 31;
        const float inv_freq = exp2f(-(float)f * (13.287712379549449f / 32.f));
        const float ang = (ax == 0 ? (float)(t >> 6) : (float)(t & 63)) * inv_freq;
        f32x2 cs2; cs2.x = cosf(ang); cs2.y = sinf(ang); *(f32x2*)(c.fp(WS_ROPE) + (size_t)i * 2) = cs2; }
    weights_range(c, 0, c.bid, c.G, WT_TILES, 1 << 30, lds);
}

__device__ __forceinline__ void load_row32(f32x4 (&v)[8], const void* base, bool isf32, size_t rowoff, int lane) {
    if (isf32) { const float* p = (const float*)base + rowoff + lane * 8;
#pragma unroll
        for (int i = 0; i < 4; ++i) { v[2 * i] = *(const f32x4*)(p + i * 512); v[2 * i + 1] = *(const f32x4*)(p + i * 512 + 4); } }
    else { const bf16_t* p = (const bf16_t*)base + rowoff + lane * 8;
#pragma unroll
        for (int i = 0; i < 4; ++i) { const u32x4 xb = *(const u32x4*)(p + i * 512);
            v[2 * i] = (f32x4){lo_f(xb.x), hi_f(xb.x), lo_f(xb.y), hi_f(xb.y)}; v[2 * i + 1] = (f32x4){lo_f(xb.z), hi_f(xb.z), lo_f(xb.w), hi_f(xb.w)}; } }
}
__device__ void phase_norm(const Ctx& c, const void* xlat, bool lat_f32, const void* xctx, bool ctx_f32, const float* __restrict__ g, const float* __restrict__ mod, int sh_off, int sc_off,
                           bf16_t* __restrict__ dst, int nrows, const float* part) {
    bf16_t* XW = c.bfp(WS_XW);
    for (int row = c.bid * 8 + c.wave; row < nrows; row += c.G * 8) {
        f32x4 v[8];
        if (row < TL) load_row32(v, xlat, lat_f32, (size_t)row * DM, c.lane); else load_row32(v, xctx, ctx_f32, (size_t)(row - TL) * DM, c.lane);
        if (part != nullptr && row >= TL) {
            const float* pr = part + (size_t)(row - TL) * DM + c.lane * 8; bf16_t* xo = XW + (size_t)row * DM + c.lane * 8;
#pragma unroll
            for (int i = 0; i < 4; ++i) {
#pragma unroll
                for (int sp = 0; sp < 8; ++sp) { v[2 * i] += *(const f32x4*)(pr + (size_t)sp * TC * DM + i * 512); v[2 * i + 1] += *(const f32x4*)(pr + (size_t)sp * TC * DM + i * 512 + 4); }
                u32x4 w; w.x = cvt_pk_bf16(v[2 * i][0], v[2 * i][1]); w.y = cvt_pk_bf16(v[2 * i][2], v[2 * i][3]); w.z = cvt_pk_bf16(v[2 * i + 1][0], v[2 * i + 1][1]); w.w = cvt_pk_bf16(v[2 * i + 1][2], v[2 * i + 1][3]);
                *(u32x4*)(xo + i * 512) = w;
                __builtin_amdgcn_sched_barrier(0); }
        }
        float ss = 0.f;
#pragma unroll
        for (int i = 0; i < 8; ++i) ss += v[i][0] * v[i][0] + v[i][1] * v[i][1] + v[i][2] * v[i][2] + v[i][3] * v[i][3];
        ss = wave_sum(ss, c.lane);
        const float rstd = rsqrtf(ss * (1.f / DM) + EPS);
        const int r = row < TL ? (row >> 11) : 4;
        const float* md = mod + (size_t)r * MODW + c.lane * 8;
#pragma unroll
        for (int i = 0; i < 4; ++i) { const int cc = i * 512;
            f32x4 y[2];
#pragma unroll
            for (int h = 0; h < 2; ++h) { const f32x4 gg = *(const f32x4*)(g + cc + c.lane * 8 + 4 * h), sh = *(const f32x4*)(md + sh_off + cc + 4 * h), sc = *(const f32x4*)(md + sc_off + cc + 4 * h);
#pragma unroll
                for (int j = 0; j < 4; ++j) y[h][j] = v[2 * i + h][j] * rstd * gg[j] * (1.f + sc[j]) + sh[j]; }
            u32x4 w; w.x = cvt_pk_bf16(y[0][0], y[0][1]); w.y = cvt_pk_bf16(y[0][2], y[0][3]); w.z = cvt_pk_bf16(y[1][0], y[1][1]); w.w = cvt_pk_bf16(y[1][2], y[1][3]);
            *(u32x4*)(dst + (size_t)row * DM + cc + c.lane * 8) = w; }
    }
}

__device__ void phase_final(const Ctx& c) {
    const bf16_t* xw = c.bfp(WS_XW); const float* g = c.p->in[22]; float* out = c.p->out;
    for (int row = c.bid * 8 + c.wave; row < TL; row += c.G * 8) {
        f32x4 v[8]; load_row32(v, xw, false, (size_t)row * DM, c.lane);
        float ss = 0.f;
#pragma unroll
        for (int i = 0; i < 8; ++i) ss += v[i][0] * v[i][0] + v[i][1] * v[i][1] + v[i][2] * v[i][2] + v[i][3] * v[i][3];
        ss = wave_sum(ss, c.lane);
        const float rstd = rsqrtf(ss * (1.f / DM) + EPS);
#pragma unroll
        for (int i = 0; i < 8; ++i) { const int cc = (i >> 1) * 512 + c.lane * 8 + 4 * (i & 1); const f32x4 gg = *(const f32x4*)(g + cc); f32x4 y;
#pragma unroll
            for (int j = 0; j < 4; ++j) y[j] = v[i][j] * rstd * gg[j];
            *(f32x4*)(out + (size_t)row * DM + cc) = y; }
    }
}

__device__ __forceinline__ u32x4 kv_share8(const float* p) {
    f32x4 a = *(const f32x4*)p, b = *(const f32x4*)(p + 4);
#pragma unroll
    for (int sp = 1; sp < 8; ++sp) { a += *(const f32x4*)(p + (size_t)sp * TC * 1024); b += *(const f32x4*)(p + (size_t)sp * TC * 1024 + 4); }
    u32x4 w; w.x = cvt_pk_bf16(a[0], a[1]); w.y = cvt_pk_bf16(a[2], a[3]); w.z = cvt_pk_bf16(b[0], b[1]); w.w = cvt_pk_bf16(b[2], b[3]); return w;
}

__device__ void phase_post(const Ctx& c, int l, bool ctx_full) {
    const KParams pk = c.p;
    const bf16_t* Z = c.bfp(WS_Z);
    bf16_t* Qo = c.bfp(WS_Q); bf16_t* Ko = c.bfp(WS_K); bf16_t* Vo = c.bfp(WS_V); bf16_t* VN = c.bfp(WS_VN);
    bf16_t* AM0 = c.bfp(WS_AM); bf16_t* AM1 = c.bfp(WS_AM + (size_t)TT * 1024 * 2);
    const int l16 = c.lane & 15, grp = c.lane >> 4, axis = l16 >> 3, fb = (l16 & 3) * 8;
    const bool firsth = (l16 & 4) == 0;
    float gqo[8], gqp[8], gko[8], gkp[8];
#pragma unroll
    for (int i = 0; i < 8; ++i) { gqo[i] = pk->in[8][l * 128 + 8 * l16 + i]; gqp[i] = pk->in[8][l * 128 + 8 * (l16 ^ 4) + i]; gko[i] = pk->in[9][l * 128 + 8 * l16 + i]; gkp[i] = pk->in[9][l * 128 + 8 * (l16 ^ 4) + i]; }
    const float* rope = c.fp(WS_ROPE);
    const float* kvp = c.fp(WS_AM + (size_t)2 * TT * 1024 * 2);
    const float* gv = pk->in[12] + l * 1024; const float* wsc = pk->in[13] + (size_t)l * 3 * 1024;
    for (int row = c.bid * 8 + c.wave; row < TT; row += c.G * 8) {
        const bool lat = row < TL; int b, t, slen;
        if (lat) { b = row >> 11; t = row & 2047; slen = SEQL; } else { b = (row - TL) >> 8; t = (row - TL) & 255; slen = CTXL; }
        const bool full = lat || ctx_full;
        const bf16_t* zr = Z + (size_t)row * IN_DIM;
        float cs[8], sn[8];
        if (lat) { const float* rp = rope + ((size_t)t * 64 + axis * 32 + fb) * 2;
#pragma unroll
            for (int i = 0; i < 4; ++i) { const f32x4 v = *(const f32x4*)(rp + i * 4); cs[2 * i] = v[0]; sn[2 * i] = v[1]; cs[2 * i + 1] = v[2]; sn[2 * i + 1] = v[3]; } }
        else {
#pragma unroll
            for (int i = 0; i < 8; ++i) { cs[i] = 1.f; sn[i] = 0.f; } }
        const size_t kvrow = (size_t)b * SKV + (lat ? t : SEQL + t);
        for (int p = full ? 0 : 4; p < 5; ++p) {
            const int hd = 4 * p + grp;
            u32x4 raw;
            if (full) raw = *(const u32x4*)(zr + hd * 128 + 8 * l16);
            else raw = kv_share8(kvp + (size_t)(row - TL) * 1024 + grp * 128 + 8 * l16);
            float own[8] = {lo_f(raw.x), hi_f(raw.x), lo_f(raw.y), hi_f(raw.y), lo_f(raw.z), hi_f(raw.z), lo_f(raw.w), hi_f(raw.w)};
            float ss = 0.f;
#pragma unroll
            for (int i = 0; i < 8; ++i) ss += own[i] * own[i];
#pragma unroll
            for (int o = 8; o; o >>= 1) ss += __int_as_float(__builtin_amdgcn_ds_bpermute((c.lane ^ o) << 2, __float_as_int(ss)));
            const float rstd = rsqrtf(ss * (1.f / 128.f) + EPS);
            u32x4 pr;
            pr.x = (unsigned)__builtin_amdgcn_ds_bpermute((c.lane ^ 4) << 2, (int)raw.x); pr.y = (unsigned)__builtin_amdgcn_ds_bpermute((c.lane ^ 4) << 2, (int)raw.y);
            pr.z = (unsigned)__builtin_amdgcn_ds_bpermute((c.lane ^ 4) << 2, (int)raw.z); pr.w = (unsigned)__builtin_amdgcn_ds_bpermute((c.lane ^ 4) << 2, (int)raw.w);
            const float par[8] = {lo_f(pr.x), hi_f(pr.x), lo_f(pr.y), hi_f(pr.y), lo_f(pr.z), hi_f(pr.z), lo_f(pr.w), hi_f(pr.w)};
            float o8[8];
#pragma unroll
            for (int i = 0; i < 8; ++i) { const float on = own[i] * rstd * (p < 4 ? gqo[i] : gko[i]), pn = par[i] * rstd * (p < 4 ? gqp[i] : gkp[i]);
                o8[i] = firsth ? on * cs[i] - pn * sn[i] : on * cs[i] + pn * sn[i]; }
            u32x4 w; w.x = cvt_pk_bf16(o8[0], o8[1]); w.y = cvt_pk_bf16(o8[2], o8[3]); w.z = cvt_pk_bf16(o8[4], o8[5]); w.w = cvt_pk_bf16(o8[6], o8[7]);
            if (p < 4) *(u32x4*)(Qo + (size_t)row * DM + hd * 128 + 8 * l16) = w;
            else *(u32x4*)(Ko + kvrow * 512 + grp * 128 + 8 * l16) = w;
        }
        if (!full) *(u32x4*)(Vo + kvrow * 512 + c.lane * 8) = kv_share8(kvp + (size_t)(row - TL) * 1024 + 512 + c.lane * 8);
        if (full) {
            float fv[16]; float ss = 0.f;
#pragma unroll
            for (int i = 0; i < 2; ++i) { const int cc = i * 512 + c.lane * 8;
                const u32x4 zv = *(const u32x4*)(zr + OFF_GV + cc);
                fv[i * 8 + 0] = gelu_tanh(lo_f(zv.x)); fv[i * 8 + 1] = gelu_tanh(hi_f(zv.x)); fv[i * 8 + 2] = gelu_tanh(lo_f(zv.y)); fv[i * 8 + 3] = gelu_tanh(hi_f(zv.y));
                fv[i * 8 + 4] = gelu_tanh(lo_f(zv.z)); fv[i * 8 + 5] = gelu_tanh(hi_f(zv.z)); fv[i * 8 + 6] = gelu_tanh(lo_f(zv.w)); fv[i * 8 + 7] = gelu_tanh(hi_f(zv.w));
#pragma unroll
                for (int j = 0; j < 8; ++j) ss += fv[i * 8 + j] * fv[i * 8 + j]; }
            ss = wave_sum(ss, c.lane); const float rstd = rsqrtf(ss * (1.f / 1024.f) + EPS);
#pragma unroll
            for (int i = 0; i < 2; ++i) { const int cc = i * 512 + c.lane * 8;
                const f32x4 g0 = *(const f32x4*)(gv + cc), g1 = *(const f32x4*)(gv + cc + 4);
                u32x4 w;
                w.x = cvt_pk_bf16(fv[i * 8 + 0] * rstd * g0[0], fv[i * 8 + 1] * rstd * g0[1]); w.y = cvt_pk_bf16(fv[i * 8 + 2] * rstd * g0[2], fv[i * 8 + 3] * rstd * g0[3]);
                w.z = cvt_pk_bf16(fv[i * 8 + 4] * rstd * g1[0], fv[i * 8 + 5] * rstd * g1[1]); w.w = cvt_pk_bf16(fv[i * 8 + 6] * rstd * g1[2], fv[i * 8 + 7] * rstd * g1[3]);
                *(u32x4*)(VN + (size_t)row * 1024 + cc) = w; }
#pragma unroll
            for (int i = 0; i < 2; ++i) { const int cc = i * 512 + c.lane * 8;
                float a[8] = {0.f, 0.f, 0.f, 0.f, 0.f, 0.f, 0.f, 0.f};
#pragma unroll
                for (int k = 0; k < 3; ++k) { const int tt = t + k - 1;
                    if (tt >= 0 && tt < slen) { const bf16_t* z2 = zr + (ptrdiff_t)(k - 1) * IN_DIM;
                        const u32x4 cg = *(const u32x4*)(z2 + OFF_CC + cc), hh = *(const u32x4*)(z2 + OFF_CH + cc);
                        const f32x4 w0 = *(const f32x4*)(wsc + k * 1024 + cc), w1 = *(const f32x4*)(wsc + k * 1024 + cc + 4);
                        a[0] += w0[0] * lo_f(cg.x) * lo_f(hh.x); a[1] += w0[1] * hi_f(cg.x) * hi_f(hh.x); a[2] += w0[2] * lo_f(cg.y) * lo_f(hh.y); a[3] += w0[3] * hi_f(cg.y) * hi_f(hh.y);
                        a[4] += w1[0] * lo_f(cg.z) * lo_f(hh.z); a[5] += w1[1] * hi_f(cg.z) * hi_f(hh.z); a[6] += w1[2] * lo_f(cg.w) * lo_f(hh.w); a[7] += w1[3] * hi_f(cg.w) * hi_f(hh.w); } }
                const u32x4 bg = *(const u32x4*)(zr + OFF_CB + cc);
                u32x4 w;
                w.x = cvt_pk_bf16(a[0] * lo_f(bg.x), a[1] * hi_f(bg.x)); w.y = cvt_pk_bf16(a[2] * lo_f(bg.y), a[3] * hi_f(bg.y));
                w.z = cvt_pk_bf16(a[4] * lo_f(bg.z), a[5] * hi_f(bg.z)); w.w = cvt_pk_bf16(a[6] * lo_f(bg.w), a[7] * hi_f(bg.w));
                *(u32x4*)(AM1 + (size_t)row * 1024 + cc) = w; }
        }
    }
}

__device__ void gmlp_unit(const Ctx& c, int tid, int l, int ch, int g, unsigned short* T) {
    const KParams pk = c.p;
    const int lane = tid & 63, wave = tid >> 6;
    const int r32 = lane & 31, hi = lane >> 5, pblk = wave >> 1, cb0 = (wave & 1) * 2;
    const float* wsr = pk->in[10] + ((size_t)(l * 8 + g) * 128 + pblk * 32 + r32) * 128 + hi * 8;
    const bf16_t* vn = c.bfp(WS_VN) + (size_t)(ch * 128) * 1024 + g * 128;
    bf16_t* AM0 = c.bfp(WS_AM);
    {
        const int q = tid >> 4, c8 = (tid & 15) * 8;
        u32x4 v[4];
#pragma unroll
        for (int ps = 0; ps < 4; ++ps) v[ps] = *(const u32x4*)(vn + (size_t)(q + 32 * ps) * 1024 + c8);
#pragma unroll
        for (int ps = 0; ps < 4; ++ps) { unsigned short* d = T + (q + 32 * ps) * 132 + c8; *(u32x2*)d = (u32x2){v[ps].x, v[ps].y}; *(u32x2*)(d + 4) = (u32x2){v[ps].z, v[ps].w}; }
    }
    bf16x8 af[8];
#pragma unroll
    for (int ks = 0; ks < 8; ++ks) { const f32x4 a0 = *(const f32x4*)(wsr + ks * 16), a1 = *(const f32x4*)(wsr + ks * 16 + 4);
        u32x4 aw; aw.x = cvt_pk_bf16(a0[0], a0[1]); aw.y = cvt_pk_bf16(a0[2], a0[3]); aw.z = cvt_pk_bf16(a1[0], a1[1]); aw.w = cvt_pk_bf16(a1[2], a1[3]);
        af[ks] = *reinterpret_cast<const bf16x8*>(&aw); }
    __syncthreads();
    f32x16 acc0 = {}, acc1 = {};
    const unsigned short* tb = T + (hi * 8) * 132 + cb0 * 32 + r32;
#pragma unroll
    for (int ks = 0; ks < 8; ++ks) {
        bf16x8 b0, b1;
#pragma unroll
        for (int j = 0; j < 8; ++j) { b0[j] = (short)tb[(ks * 16 + j) * 132]; b1[j] = (short)tb[(ks * 16 + j) * 132 + 32]; }
        acc0 = __builtin_amdgcn_mfma_f32_32x32x16_bf16(af[ks], b0, acc0, 0, 0, 0);
        acc1 = __builtin_amdgcn_mfma_f32_32x32x16_bf16(af[ks], b1, acc1, 0, 0, 0); }
#pragma unroll
    for (int r = 0; r < 16; ++r) { const int prow = pblk * 32 + att::crow(r, hi); const size_t t = (size_t)ch * 128 + prow;
        const float bias = pk->in[11][(l * 8 + g) * 128 + prow];
        bf16_t* up = AM0 + t * 1024 + g * 128 + cb0 * 32 + r32;
        up[0] = f2bf(bf2f(up[0]) * (acc0[r] + bias)); up[32] = f2bf(bf2f(up[32]) * (acc1[r] + bias)); }
    __syncthreads();
}

__device__ void phase_attn(const Ctx& c, int l, bool with_ctx, char* lds, bool skip_gmlp) {
    const bf16_t* Qb = c.bfp(WS_Q); const bf16_t* Kb = c.bfp(WS_K); const bf16_t* Vb = c.bfp(WS_V); bf16_t* AM = c.bfp(WS_AM);
    const int nun = with_ctx ? 576 : 512;
    for (int i = 0; ; ++i) {
        const int L = i * c.G + c.bid; if (L >= nun) break;
        int b, h, seq; size_t qrow, kvrow;
        if (L < 512) {
            if (c.G == 256) { const int xcd = c.bid & 7, slot = c.bid >> 3, grp = i * 8 + xcd; b = grp >> 2; h = (grp & 3) * 4 + (slot >> 3); qrow = (size_t)b * SEQL + (slot & 7) * 256; }
            else { b = L >> 7; h = (L >> 3) & 15; qrow = (size_t)b * SEQL + (L & 7) * 256; }
            kvrow = (size_t)b * SKV; seq = SKV;
        } else { const int u = L - 512; b = u >> 4; h = u & 15; qrow = (size_t)TL + b * CTXL; kvrow = (size_t)b * SKV + SEQL; seq = CTXL; }
        const int kvh = h >> 2;
        att::attn_dense_body(Qb + qrow * DM + h * 128, Kb + kvrow * 512 + kvh * 128, Vb + kvrow * 512 + kvh * 128,
                             AM + (size_t)(2 + (h >> 3)) * TT * 1024 + qrow * 1024 + (h & 7) * 128, seq, lds, c.tid);
    }
    if (skip_gmlp) return;
    const int nch = with_ctx ? 72 : 64;
#ifndef NO_GMLP
    int t2 = c.tid; asm volatile("" : "+v"(t2));
    const int shift = (with_ctx && c.G == 256) ? 64 : 0;
    for (int u = c.bid; u < nch * 8; u += c.G) {
        int uu = u;
        if (u >= 512 && shift) continue;
        gmlp_unit(c, t2, l, uu >> 3, uu & 7, (unsigned short*)lds);
    }
    if (shift && c.bid >= 64 && c.bid < 128) { const int uu = 512 + c.bid - 64; gmlp_unit(c, t2, l, uu >> 3, uu & 7, (unsigned short*)lds); }
#endif
}

__device__ void phase_ffnfix(const Ctx& c, int l, int nrows) {
    bf16_t* Gb = c.bfp(WS_AM); const float* ED = c.fp(WS_EDGE);
    const float* wcv = c.p->in[20] + (size_t)l * 3 * DFF2;
    constexpr int NCH = DFF / 8;
    const int total = (nrows / 64) * 2 * NCH;
    for (int idx = c.bid * NTHR + c.tid; idx < total; idx += c.G * NTHR) {
        const int be = idx / NCH, chn = idx - be * NCH, j = chn * 8, blk = be >> 1, e = be & 1;
        const int row = blk * 64 + (e ? 63 : 0);
        int t, slen; if (row < TL) { t = row & (SEQL - 1); slen = SEQL; } else { t = (row - TL) & (CTXL - 1); slen = CTXL; }
        const bool nbv = e ? (t + 1 < slen) : (t > 0);
        const float* eb = ED + (size_t)(be * 4) * DFF + j;
        const float* nb = ED + (size_t)(((e ? blk + 1 : blk - 1) * 2 + (e ? 0 : 1)) * 4 + 2) * DFF + j;
        const float* wk = wcv + (size_t)(e ? 2 : 0) * DFF2 + j;
        f32x4 ca0 = *(const f32x4*)eb, ca1 = *(const f32x4*)(eb + 4), cb0 = *(const f32x4*)(eb + DFF), cb1 = *(const f32x4*)(eb + DFF + 4);
        if (nbv) { ca0 += *(const f32x4*)wk * *(const f32x4*)nb; ca1 += *(const f32x4*)(wk + 4) * *(const f32x4*)(nb + 4);
                   cb0 += *(const f32x4*)(wk + DFF) * *(const f32x4*)(nb + DFF); cb1 += *(const f32x4*)(wk + DFF + 4) * *(const f32x4*)(nb + DFF + 4); }
        float y[8];
#pragma unroll
        for (int q = 0; q < 4; ++q) { y[q] = ca0[q] * sigmoidf_(ca0[q]) * cb0[q]; y[4 + q] = ca1[q] * sigmoidf_(ca1[q]) * cb1[q]; }
        u32x4 w; w.x = cvt_pk_bf16(y[0], y[1]); w.y = cvt_pk_bf16(y[2], y[3]); w.z = cvt_pk_bf16(y[4], y[5]); w.w = cvt_pk_bf16(y[6], y[7]);
        *(u32x4*)(Gb + (size_t)row * DFF + j) = w;
    }
}

constexpr int PH_PER_LAYER = 10, NPH = 1 + 2 * PH_PER_LAYER + 1;
#ifndef PH_MASK
#define PH_MASK 0xFFFF
#endif
#define PH_EN(n) ((PH_MASK >> (n)) & 1)

__device__ void ctx_m_convert(const Ctx& c, unsigned* cnt) {
    const float* ps = c.fp(WS_Q); bf16_t* mh = c.bfp(WS_H) + (size_t)TL * DM;
    for (int i = c.bid * NTHR + c.tid; i < TC * DM / 8; i += c.G * NTHR) {
        const float* q = ps + (size_t)i * 8;
        f32x4 a = *(const f32x4*)q, b = *(const f32x4*)(q + 4);
#pragma unroll
        for (int sg = 1; sg < 4; ++sg) { a += *(const f32x4*)(q + (size_t)sg * TC * DM); b += *(const f32x4*)(q + (size_t)sg * TC * DM + 4); }
        u32x4 w; w.x = cvt_pk_bf16(a[0], a[1]); w.y = cvt_pk_bf16(a[2], a[3]); w.z = cvt_pk_bf16(b[0], b[1]); w.w = cvt_pk_bf16(b[2], b[3]);
        *(u32x4*)(mh + (size_t)i * 8) = w; }
    asm volatile("s_waitcnt vmcnt(0)" ::: "memory");
    __syncthreads();
    if (c.tid == 0) { __builtin_amdgcn_fence(__ATOMIC_RELEASE, "agent"); asm volatile("s_waitcnt vmcnt(0)" ::: "memory"); (void)xb_add(cnt, 1u); }
}

template <int PH, bool RERUN>
__device__ __forceinline__ void run_phase(unsigned char* shm, int vbid, int wave_s) {
    unsigned z_ = 0u; int ws_ = wave_s; asm volatile("" : "+s"(z_)); asm volatile("" : "+s"(ws_));
    int tid_ = (ws_ << 6) | (int)__builtin_amdgcn_mbcnt_hi(~0u, __builtin_amdgcn_mbcnt_lo(~0u, z_)), bid_ = __builtin_amdgcn_readfirstlane(vbid);
    KParams pp_ = (KParams)__builtin_amdgcn_kernarg_segment_ptr();
    asm volatile("" : "+v"(tid_)); asm volatile("" : "+s"(bid_)); asm volatile("" : "+s"(pp_));
    Ctx c; c.p = pp_; c.ws = pp_->ws; c.bid = bid_; c.G = gridDim.x; c.tid = tid_; c.lane = tid_ & 63; c.wave = tid_ >> 6;
    LAS unsigned char* lds3 = (LAS unsigned char*)shm;
    if constexpr (PH == 0) { if (PH_EN(10)) phase_prep(c, (float*)shm); }
    else if constexpr (PH == NPH - 1) { if (PH_EN(11)) phase_final(c); }
    else {
        constexpr int l = (PH - 1) / PH_PER_LAYER, s = (PH - 1) % PH_PER_LAYER;
        constexpr bool last = (l == 1);
        const float* mod = c.fp(WS_MOD) + (size_t)l * 5 * MODW;
        constexpr int rows = last ? TL : TT;
        if constexpr (s == 0) { if (PH_EN(0)) phase_norm(c, l == 0 ? (const void*)c.p->in[0] : (const void*)c.bfp(WS_XW), l == 0, l == 0 ? (const void*)c.p->in[2] : (const void*)(c.bfp(WS_XW) + (size_t)TL * DM), l == 0, c.p->in[6] + l * DM, mod, 0, DM, c.bfp(WS_H), TT, l == 0 ? nullptr : c.fp(WS_Z));
                                if (last) weights_range(c, 1, (c.G == 256 ? WTC_END : 0) + c.bid, c.G, WT_TILES, 1 << 30, (float*)shm); }
        if constexpr (s == 1) { if (PH_EN(1)) { pg8::Order S; S.init(rows, IN_DIM, DM, c.G, c.bid, c.bfp(WS_H), c.bfp(WS_WIN + l * SZ_WIN));
                  if (last) { S.xM0 = 32; S.xnM = 4; S.xN0 = 8; S.xnN = 4; S.xsplit = 8; }
                  pg8::EpiBf16 E; E.O = c.bfp(WS_Z); E.ldc = IN_DIM; E.PART = c.fp(WS_AM + (size_t)2 * TT * 1024 * 2); E.U = c.bfp(WS_AM); E.V = c.bfp(WS_V);
                  pg8::gemm_phase(lds3, c.tid, DM, S, E);
                  if (!last && c.G == 256 && c.bid >= 224) weights_range(c, 1, c.bid - 224, 32, WTA_END, WTA_N, (float*)shm); } }
        if constexpr (s == 2) { if (PH_EN(2)) phase_post(c, l, !last); }
        if constexpr (s == 3) { if (PH_EN(3)) phase_attn(c, l, !last, (char*)shm, RERUN); }
        if constexpr (s == 4) { if (PH_EN(4)) { pg8::Order S; S.init(TL, DM, 1024, c.G, c.bid, c.bfp(WS_AM), c.bfp(WS_WM + l * SZ_WM));
                  S.nseg = 4; S.segA = (size_t)TT * 1024 * 2; S.segB = SZ_WM / 4;
                  if (!last) { S.xM0 = 32; S.xnM = 4; S.xN0 = 0; S.xnN = 8; S.xseg = 4; }
                  pg8::EpiMerge E; E.O = c.bfp(WS_H); E.Z = c.bfp(WS_Z); E.PARTM = c.fp(WS_Q);
                  pg8::gemm_phase(lds3, c.tid, 1024, S, E);
                  if (!last && c.G == 256 && c.bid >= 128) weights_range(c, 1, WTA_END + c.bid - 128, 128, WTB_END, WTB_N, (float*)shm); } }
        if constexpr (s == 5) { if (PH_EN(5)) { pg8::Order S; S.init(TL, DM, DM, c.G, c.bid, c.bfp(WS_H), c.bfp(WS_WO + l * SZ_WO));
                  if (!last) { S.xM0 = 32; S.xnM = 4; S.xN0 = 0; S.xnN = 8; S.xsplit = 8; S.wait_cnt = (unsigned*)(c.ws + WS_BAR) + 96; S.wait_need = (unsigned)c.G;
                               ctx_m_convert(c, S.wait_cnt); }
                  pg8::EpiResid E; E.X = c.bfp(WS_XW); E.Xf32 = l == 0 ? c.p->in[0] : nullptr; E.mod = mod; E.gate_off = 2 * DM; E.PART = c.fp(WS_Z);
                  pg8::gemm_phase(lds3, c.tid, DM, S, E); } }
        if constexpr (s == 6) { if (PH_EN(6)) phase_norm(c, c.bfp(WS_XW), false, c.p->in[2], true, c.p->in[18] + l * DM, mod, 3 * DM, 4 * DM, c.bfp(WS_H), rows, last ? nullptr : c.fp(WS_Z)); }
        if constexpr (s == 7) { if (PH_EN(7)) { pg8::Order S; S.init(rows, DFF2, DM, c.G, c.bid, c.bfp(WS_H), c.bfp(WS_WUP + l * SZ_WUP));
                  pg8::EpiFfn E; E.G = c.bfp(WS_AM); E.EDGE = c.fp(WS_EDGE); E.wcv = c.p->in[20] + (size_t)l * 3 * DFF2;
                  pg8::gemm_phase(lds3, c.tid, DM, S, E);
                  if (!last && c.G == 256 && c.bid >= 12) weights_range(c, 1, WTB_END + c.bid - 12, 244, WTC_END, WTC_N, (float*)shm); } }
        if constexpr (s == 8) { if (PH_EN(8)) phase_ffnfix(c, l, rows); }
        if constexpr (s == 9) { if (PH_EN(9)) { pg8::Order S; S.init(TL, DM, DFF, c.G, c.bid, c.bfp(WS_AM), c.bfp(WS_WDN + l * SZ_WDN));
                  if (!last) { S.xM0 = 32; S.xnM = 4; S.xN0 = 0; S.xnN = 8; S.xsplit = 8; }
                  pg8::EpiResid E; E.X = c.bfp(WS_XW); E.Xf32 = nullptr; E.mod = mod; E.gate_off = 5 * DM; E.PART = c.fp(WS_Z);
                  pg8::gemm_phase(lds3, c.tid, DFF, S, E); } }
    }
}

__global__ void __launch_bounds__(NTHR, 2) mega(Params p) {
    extern __shared__ __attribute__((aligned(16))) unsigned char shm[];
    cg::grid_group grid = cg::this_grid();
    volatile LAS unsigned* st = (volatile LAS unsigned*)((LAS unsigned char*)shm + LDS_GEMM);
    const int wave_s = __builtin_amdgcn_readfirstlane((int)threadIdx.x >> 6);
    const bool t0 = wave_s == 0 && lane_id_() == 0;
    if (t0) { st[0] = 0u; st[1] = 0u; }
    __syncthreads();
    const XcdBarrier xb = xcd_barrier_post((unsigned*)(p.ws + WS_BAR), st, wave_s);
#ifndef DBL_MASK
#define DBL_MASK 0
#endif
    int vbid = blockIdx.x;
    if (t0) st[2] = xb_add((unsigned*)(p.ws + WS_BAR) + 64 + xb.x, 1u);
    if (p.ph_hi < 0) grid.sync();
#define STEP(k) { if ((k) == 1) { xcd_barrier(xb); \
            unsigned* tk = (unsigned*)(p.ws + WS_BAR) + 64; bool ok = (gridDim.x & 7) == 0; \
            for (int j = 0; j < 8; ++j) ok = ok && (xb_ld(tk + j) == gridDim.x / 8); \
            if (ok) vbid = (int)(st[2] * 8u + xb.x); } \
        else if ((k) > 1) xcd_barrier(xb); run_phase<(k), false>(shm, (k) == 0 ? (int)blockIdx.x : vbid, wave_s); \
        if ((DBL_MASK >> (k)) & 1) { xcd_barrier(xb); run_phase<(k), true>(shm, (k) == 0 ? (int)blockIdx.x : vbid, wave_s); } }
    STEP(0) STEP(1) STEP(2) STEP(3) STEP(4) STEP(5) STEP(6) STEP(7) STEP(8) STEP(9) STEP(10)
    STEP(11) STEP(12) STEP(13) STEP(14) STEP(15) STEP(16) STEP(17) STEP(18) STEP(19) STEP(20) STEP(21)
#undef STEP
}

#ifndef MK_MULTI
#define MK_MULTI 0
#endif
extern "C" void kernel_launch(void* const* d_in, const int* in_sizes, int n_in, void* d_out, int out_size, void* d_ws, size_t ws_size, hipStream_t stream) {
    static int grid = 0;
    if (grid == 0) {
        if (n_in != 23 || out_size != TL * DM || ws_size < WS_END) { fprintf(stderr, "kernel_launch: unexpected shapes (n_in %d out %d ws %zu need %zu)\n", n_in, out_size, ws_size, (size_t)WS_END); grid = -1; return; }
        int dev = 0, cus = 0, per_cu = 0;
        hipGetDevice(&dev); hipDeviceGetAttribute(&cus, hipDeviceAttributeMultiprocessorCount, dev);
        if (hipFuncSetAttribute((const void*)mega, hipFuncAttributeMaxDynamicSharedMemorySize, LDS_BYTES) != hipSuccess) { fprintf(stderr, "kernel_launch: hipFuncSetAttribute failed\n"); grid = -1; return; }
        if (hipOccupancyMaxActiveBlocksPerMultiprocessor(&per_cu, (const void*)mega, NTHR, LDS_BYTES) != hipSuccess || per_cu < 1) { fprintf(stderr, "kernel_launch: occupancy query says %d\n", per_cu); per_cu = 1; }
        (void)hipGetLastError();
        grid = cus * 1;
        if (grid <= 0) grid = 256;
    }
    if (grid < 0) return;
    if (hipMemsetAsync((unsigned char*)d_ws + WS_BAR, 0, (size_t)XCD_BAR_WORDS * 4, stream) != hipSuccess) { fprintf(stderr, "kernel_launch: memset of barrier words failed\n"); return; }
    Params p{};
    for (int i = 0; i < 23; ++i) p.in[i] = (const float*)d_in[i];
    p.out = (float*)d_out; p.ws = (unsigned char*)d_ws;
    p.ph_lo = 0; p.ph_hi = NPH;
    void* args[] = {&p};
    hipError_t e = hipLaunchCooperativeKernel((const void*)mega, dim3(grid), dim3(NTHR), args, LDS_BYTES, stream);
    if (e != hipSuccess) fprintf(stderr, "kernel_launch: cooperative launch failed: %s (grid %d)\n", hipGetErrorString(e), grid);
}
```

```cpp
#include <hip/hip_runtime.h>
#include <hip/hip_cooperative_groups.h>
#include <cstdio>
#include <cstdint>
namespace cg = cooperative_groups;

#define LAS __attribute__((address_space(3)))
typedef unsigned short bf16_t;
typedef short bf16x8 __attribute__((ext_vector_type(8)));
typedef short s16x4 __attribute__((ext_vector_type(4)));
typedef float f32x2 __attribute__((ext_vector_type(2)));
typedef float f32x4 __attribute__((ext_vector_type(4)));
typedef float f32x16 __attribute__((ext_vector_type(16)));
typedef unsigned u32x2 __attribute__((ext_vector_type(2)));
typedef unsigned u32x4 __attribute__((ext_vector_type(4)));

constexpr int DM = 2048, TL = 8192, TC = 1024, TT = 9216, SEQL = 2048, CTXL = 256, SKV = 2304;
constexpr int IN_DIM = 14336, DFF = 5504, DFF2 = 11008, MODW = 12288;
constexpr int OFF_K = 2048, OFF_V = 2560, OFF_GU = 3072, OFF_GV = 4096, OFF_CB = 5120, OFF_CC = 6144, OFF_CH = 7168, OFF_GATE = 8192;
constexpr float EPS = 1e-6f;
constexpr int NTHR = 512;
constexpr int LDS_GEMM = 131072, LDS_BYTES = LDS_GEMM + 32;
constexpr int XCD_BAR_WORDS_C = 3456;

constexpr size_t SZ_WIN = (size_t)IN_DIM * DM * 2, SZ_WM = (size_t)4 * DM * 1024 * 2, SZ_WO = (size_t)DM * DM * 2, SZ_WUP = (size_t)DFF2 * DM * 2, SZ_WDN = (size_t)DM * DFF * 2;
constexpr size_t WS_WIN = 0;
constexpr size_t WS_WM = WS_WIN + 2 * SZ_WIN;
constexpr size_t WS_WO = WS_WM + 2 * SZ_WM;
constexpr size_t WS_WUP = WS_WO + 2 * SZ_WO;
constexpr size_t WS_WDN = WS_WUP + 2 * SZ_WUP;
constexpr size_t WS_MOD = WS_WDN + 2 * SZ_WDN;
constexpr size_t WS_XW = WS_MOD + (size_t)2 * 5 * MODW * 4;
constexpr size_t WS_H = WS_XW + (size_t)TT * DM * 4;
constexpr size_t WS_Z = WS_H + (size_t)TT * DM * 2;
constexpr size_t WS_AM = WS_Z + (size_t)TT * IN_DIM * 2;
constexpr size_t WS_Q = WS_AM + (size_t)4 * TT * 1024 * 2;
constexpr size_t WS_K = WS_Q + (size_t)TT * DM * 2;
constexpr size_t WS_V = WS_K + (size_t)4 * SKV * 512 * 2;
constexpr size_t WS_VN = WS_V + (size_t)4 * SKV * 512 * 2;
constexpr size_t WS_BAR = WS_VN + (size_t)TT * 1024 * 2;
constexpr size_t WS_ROPE = ((WS_BAR + (size_t)XCD_BAR_WORDS_C * 4 + 255) / 256) * 256;
constexpr size_t WS_EDGE = WS_ROPE + (size_t)SEQL * 64 * 2 * 4;
constexpr size_t WS_END = WS_EDGE + (size_t)(TT / 64) * 2 * 2 * 2 * DFF * 4;
static_assert((size_t)TT * DFF * 2 <= (size_t)4 * TT * 1024 * 2 + (size_t)TT * DM * 2, "G alias");

struct Params {
    const float* in[23];
    float* out;
    unsigned char* ws;
    int ph_lo, ph_hi;
};

__device__ __forceinline__ unsigned cvt_pk_bf16(float lo, float hi) { unsigned r; asm volatile("v_cvt_pk_bf16_f32 %0, %1, %2" : "=v"(r) : "v"(lo), "v"(hi)); return r; }
__device__ __forceinline__ float bf2f(bf16_t b) { return __uint_as_float(((unsigned)b) << 16); }
__device__ __forceinline__ bf16_t f2bf(float f) { return (bf16_t)(cvt_pk_bf16(f, 0.f) & 0xffffu); }
__device__ __forceinline__ float wave_sum(float v, int lane) {
#pragma unroll
    for (int o = 32; o; o >>= 1) v += __int_as_float(__builtin_amdgcn_ds_bpermute((lane ^ o) << 2, __float_as_int(v)));
    return v;
}
__device__ __forceinline__ float lo_f(unsigned w) { return __uint_as_float(w << 16); }
__device__ __forceinline__ float hi_f(unsigned w) { return __uint_as_float(w & 0xffff0000u); }
__device__ __forceinline__ float gelu_tanh(float x) {
    const float y = 0.7978845608028654f * (x + 0.044715f * x * x * x);
    const float e = __expf(2.f * y);
    const float th = 1.f - 2.f / (e + 1.f);
    return 0.5f * x * (1.f + th);
}
__device__ __forceinline__ float sigmoidf_(float x) { return 1.f / (1.f + __expf(-x)); }

namespace pg8 {
constexpr int BM = 256, BK = 64, HALF = 128, HTB = HALF * BK * 2, STAGE_BYTES = 8 * HTB, NXCD = 8, WGM = 8;
__host__ __device__ __forceinline__ int lds_byte(int r, int c) { const int st = (r >> 4) * 2 + (c >> 5), rr = r & 15, cc = c & 31, ob = rr * 64 + cc * 2; return st * 1024 + (ob ^ (((ob >> 9) & 1) << 5)); }
__host__ __device__ __forceinline__ void stage_rc(int b, int& R, int& C) { const int st = b / 1024, sb = b % 1024, swz = sb ^ (((sb >> 9) & 1) << 5); R = (st >> 1) * 16 + swz / 64; C = (st & 1) * 32 + (swz % 64) / 2; }
__host__ __device__ __forceinline__ int perm32(int rho) { const int n = rho >> 4, i = rho & 15; return 8 * (i >> 2) + 4 * n + (i & 3); }

struct Unit { int pm, pn, seg, ks; };

struct Order {
    int nM, nN, nwg, G, c, nseg;
    int xM0, xN0, xnM, xnN, xsplit, xseg, ntf, sbase, sthr;
    const char* A; const char* B; const char* A2; size_t tstep, segA, segB, a2pn;
    unsigned* wait_cnt; unsigned wait_need;
    __device__ void init(int M, int N, int K, int G_, int c_, const void* A_, const void* B_) {
        nM = M / BM; nN = N / BM; nwg = nM * nN; G = G_; c = c_; nseg = 1; xM0 = xN0 = xnM = xnN = 0; xsplit = 1; xseg = 0; A2 = nullptr; a2pn = 0; wait_cnt = nullptr; wait_need = 0; ntf = K / BK; sbase = ((ntf / 8) & ~1); sthr = 8 - (ntf - 8 * sbase) / 2; A = (const char*)A_; B = (const char*)B_; tstep = (size_t)BM * K * 2; segA = segB = 0; }
    __device__ bool next(int i, Unit& u) const {
        const int ti = i / nseg; u.seg = i - ti * nseg; u.ks = -1;
        const long L = (long)ti * G + c;
        if (L < nwg) {
            int wgid = (int)L; { const int q = nwg / NXCD, r = nwg % NXCD, xcd = wgid % NXCD, off = wgid / NXCD; wgid = (xcd < r ? xcd * (q + 1) : r * (q + 1) + (xcd - r) * q) + off; }
            const int nig = WGM * nN, gid = wgid / nig, fm = gid * WGM, gsz = (nM - fm) < WGM ? (nM - fm) : WGM;
            u.pm = fm + ((wgid % nig) % gsz); u.pn = (wgid % nig) / gsz; return true;
        }
        const int e = (int)(L - nwg);
        if (xseg) { if (u.seg != 0) return false;
            if (e < xnM * xnN * xseg) { const int t = e / xseg; u.seg = e - t * xseg; u.pm = xM0 + t % xnM; u.pn = xN0 + t / xnM; u.ks = 0; return true; }
            return false; }
        if (e < xnM * xnN * xsplit) { const int t = e / xsplit; u.pm = xM0 + t % xnM; u.pn = xN0 + t / xnM; if (xsplit > 1) u.ks = e - t * xsplit; return true; }
        return false;
    }
    __device__ __forceinline__ int nt(const Unit& u) const { return (u.ks < 0 || xsplit == 1) ? ntf : sbase + (u.ks >= sthr ? 2 : 0); }
    __device__ __forceinline__ size_t kofs(const Unit& u) const { return (u.ks < 0 || xsplit == 1) ? (size_t)0 : (size_t)(u.ks * sbase + (u.ks > sthr ? 2 * (u.ks - sthr) : 0)) * (BK * 2); }
    __device__ __forceinline__ const char* aptr(const Unit& u) const { return (A2 != nullptr && u.ks >= 0) ? A2 + (size_t)u.pn * a2pn + (size_t)(u.pm - xM0) * tstep + kofs(u) : A + (size_t)u.seg * segA + (size_t)u.pm * tstep + kofs(u); }
    __device__ __forceinline__ void a_ready(const Unit& u, int tid) const {
        if (wait_cnt == nullptr || u.ks < 0) return;
        if (tid < 64) {
            unsigned sp = 0;
            while ((unsigned)__builtin_amdgcn_readfirstlane(__hip_atomic_load(wait_cnt, __ATOMIC_RELAXED, __HIP_MEMORY_SCOPE_AGENT)) < wait_need) { __builtin_amdgcn_s_sleep(2); if (++sp > (1u << 20)) break; }
            __builtin_amdgcn_fence(__ATOMIC_ACQUIRE, "agent");
            asm volatile("s_waitcnt vmcnt(0)" ::: "memory");
        }
        asm volatile("" ::: "memory"); __builtin_amdgcn_s_barrier(); asm volatile("" ::: "memory");
    }
    __device__ __forceinline__ const char* bptr(const Unit& u) const { return B + (size_t)u.seg * segB + (size_t)u.pn * tstep + kofs(u); }
};

struct EpiBf16 {
    static constexpr bool PERM = true;
    bf16_t* O; int ldc; float* PART;
    bf16_t* U; bf16_t* V;
    __device__ __forceinline__ bool zero_after(const Unit&) const { return true; }
    __device__ __forceinline__ void operator()(f32x4 (&acc)[2][2][4][2], const Unit& u, int wr, int wc, int fr, int fq) const {
        const int row0 = u.pm * BM + wr * 64 + fr, col0 = u.pn * BM + wc * 32 + 8 * fq;
        if (u.ks >= 0) {
            float* pb = PART + ((size_t)u.ks * TC + (size_t)(row0 - TL)) * 1024 + (col0 - OFF_K);
#pragma unroll
            for (int ai = 0; ai < 2; ++ai)
#pragma unroll
                for (int m = 0; m < 4; ++m)
#pragma unroll
                    for (int bj = 0; bj < 2; ++bj) { float* q = pb + (size_t)(ai * HALF + m * 16) * 1024 + bj * HALF; *(f32x4*)q = acc[ai][bj][m][0]; *(f32x4*)(q + 4) = acc[ai][bj][m][1]; }
            return;
        }
        bf16_t* base = O; size_t ld = (size_t)ldc; int coff = col0, roff = 0; bool gel = false;
        if (u.pn >= 12 && u.pn < 16) { base = U; ld = 1024; coff = col0 - OFF_GU; gel = true; }
        else if (u.pn == 10 || u.pn == 11) { base = V; ld = 512; coff = col0 - OFF_V; roff = u.pm < 32 ? (u.pm >> 3) * 256 : 2048 * (u.pm - 32) - 6144; }
#pragma unroll
        for (int ai = 0; ai < 2; ++ai)
#pragma unroll
            for (int m = 0; m < 4; ++m) { bf16_t* rowp = base + (size_t)(row0 + ai * HALF + m * 16 + roff) * ld + coff;
#pragma unroll
                for (int bj = 0; bj < 2; ++bj) { f32x4 v0 = acc[ai][bj][m][0], v1 = acc[ai][bj][m][1];
                    if (gel) {
#pragma unroll
                        for (int i = 0; i < 4; ++i) { v0[i] = gelu_tanh(v0[i]); v1[i] = gelu_tanh(v1[i]); } }
                    u32x4 w; w.x = cvt_pk_bf16(v0[0], v0[1]); w.y = cvt_pk_bf16(v0[2], v0[3]); w.z = cvt_pk_bf16(v1[0], v1[1]); w.w = cvt_pk_bf16(v1[2], v1[3]);
                    *(u32x4*)(rowp + bj * HALF) = w; } }
    }
};
struct EpiResid {
    static constexpr bool PERM = true;
    bf16_t* X; float* PART; const float* Xf32; const float* mod; int gate_off;
    __device__ __forceinline__ bool zero_after(const Unit&) const { return true; }
    __device__ __forceinline__ void operator()(f32x4 (&acc)[2][2][4][2], const Unit& u, int wr, int wc, int fr, int fq) const {
        const int row0 = u.pm * BM + wr * 64 + fr, col0 = u.pn * BM + wc * 32 + 8 * fq;
        const int r = u.pm < 32 ? (u.pm >> 3) : 4;
        const float* gt = mod + (size_t)r * MODW + gate_off + col0;
        f32x4 gv[2][2];
#pragma unroll
        for (int bj = 0; bj < 2; ++bj)
#pragma unroll
            for (int n = 0; n < 2; ++n) gv[bj][n] = *(const f32x4*)(gt + bj * HALF + 4 * n);
        if (u.ks >= 0) {
            float* pb = PART + ((size_t)u.ks * TC + (size_t)(row0 - TL)) * DM + col0;
#pragma unroll
            for (int ai = 0; ai < 2; ++ai)
#pragma unroll
                for (int m = 0; m < 4; ++m)
#pragma unroll
                    for (int bj = 0; bj < 2; ++bj) { float* q = pb + (size_t)(ai * HALF + m * 16) * DM + bj * HALF;
                        *(f32x4*)q = gv[bj][0] * acc[ai][bj][m][0]; *(f32x4*)(q + 4) = gv[bj][1] * acc[ai][bj][m][1]; }
            return;
        }
#pragma unroll
        for (int ai = 0; ai < 2; ++ai)
#pragma unroll
            for (int m = 0; m < 4; ++m) { const size_t ro = (size_t)(row0 + ai * HALF + m * 16) * DM + col0;
#pragma unroll
                for (int bj = 0; bj < 2; ++bj) { f32x4 x0, x1;
                    if (Xf32 != nullptr) { x0 = *(const f32x4*)(Xf32 + ro + bj * HALF); x1 = *(const f32x4*)(Xf32 + ro + bj * HALF + 4); }
                    else { const u32x4 xb = *(const u32x4*)(X + ro + bj * HALF);
                        x0 = (f32x4){lo_f(xb.x), hi_f(xb.x), lo_f(xb.y), hi_f(xb.y)}; x1 = (f32x4){lo_f(xb.z), hi_f(xb.z), lo_f(xb.w), hi_f(xb.w)}; }
                    x0 += gv[bj][0] * acc[ai][bj][m][0]; x1 += gv[bj][1] * acc[ai][bj][m][1];
                    u32x4 w; w.x = cvt_pk_bf16(x0[0], x0[1]); w.y = cvt_pk_bf16(x0[2], x0[3]); w.z = cvt_pk_bf16(x1[0], x1[1]); w.w = cvt_pk_bf16(x1[2], x1[3]);
                    *(u32x4*)(X + ro + bj * HALF) = w; } }
    }
};
__device__ __forceinline__ float dppf(float oldv, float src, const int ctrl) {
    if (ctrl == 0x111) return __int_as_float(__builtin_amdgcn_update_dpp(__float_as_int(oldv), __float_as_int(src), 0x111, 0xf, 0xf, false));
    if (ctrl == 0x101) return __int_as_float(__builtin_amdgcn_update_dpp(__float_as_int(oldv), __float_as_int(src), 0x101, 0xf, 0xf, false));
    if (ctrl == 0x121) return __int_as_float(__builtin_amdgcn_update_dpp(__float_as_int(oldv), __float_as_int(src), 0x121, 0xf, 0xf, false));
    return __int_as_float(__builtin_amdgcn_update_dpp(__float_as_int(oldv), __float_as_int(src), 0x12F, 0xf, 0xf, false));
}
struct EpiFfn {
    static constexpr bool PERM = true;
    bf16_t* G; float* EDGE; const float* wcv;
    __device__ __forceinline__ bool zero_after(const Unit&) const { return true; }
    __device__ __forceinline__ void operator()(f32x4 (&acc)[2][2][4][2], const Unit& u, int wr, int wc, int fr, int fq) const {
        f32x4 wall[2][2][3];
#pragma unroll
        for (int n = 0; n < 2; ++n)
#pragma unroll
            for (int k = 0; k < 3; ++k) { const int jj = u.pn * 128 + wc * 32 + 8 * fq + 4 * n;
                wall[n][0][k] = *(const f32x4*)(wcv + (size_t)k * DFF2 + jj); wall[n][1][k] = *(const f32x4*)(wcv + (size_t)k * DFF2 + DFF + jj); }
#pragma unroll
        for (int n = 0; n < 2; ++n) {
            const int j0 = u.pn * 128 + wc * 32 + 8 * fq + 4 * n;
            f32x4 wa[3], wb[3];
#pragma unroll
            for (int k = 0; k < 3; ++k) { wa[k] = wall[n][0][k]; wb[k] = wall[n][1][k]; }
#pragma unroll
            for (int ai = 0; ai < 2; ++ai) {
                const int rb = u.pm * BM + ai * HALF + wr * 64, blk = rb >> 6;
#pragma unroll
                for (int m = 0; m < 4; ++m) {
                    f32x4 o, pa_, pb_;
#pragma unroll
                    for (int i = 0; i < 4; ++i) {
                        const float a0 = acc[ai][0][m][n][i], b0 = acc[ai][1][m][n][i];
                        float ap = 0.f, an = 0.f, bp = 0.f, bn = 0.f;
                        if (m > 0) { ap = dppf(0.f, acc[ai][0][m - 1][n][i], 0x121); bp = dppf(0.f, acc[ai][1][m - 1][n][i], 0x121); }
                        if (m < 3) { an = dppf(0.f, acc[ai][0][m + 1][n][i], 0x12F); bn = dppf(0.f, acc[ai][1][m + 1][n][i], 0x12F); }
                        ap = dppf(ap, a0, 0x111); bp = dppf(bp, b0, 0x111);
                        an = dppf(an, a0, 0x101); bn = dppf(bn, b0, 0x101);
                        const float ca = wa[0][i] * ap + wa[1][i] * a0 + wa[2][i] * an, cb = wb[0][i] * bp + wb[1][i] * b0 + wb[2][i] * bn;
                        pa_[i] = ca; pb_[i] = cb;
                        o[i] = ca * __builtin_amdgcn_rcpf(1.f + __expf(-ca)) * cb; }
                    u32x2 w; w.x = cvt_pk_bf16(o[0], o[1]); w.y = cvt_pk_bf16(o[2], o[3]);
                    *(u32x2*)(G + (size_t)(rb + m * 16 + fr) * DFF + j0) = w;
                    if ((m == 0 && fr == 0) || (m == 3 && fr == 15)) {
                        float* eb = EDGE + (size_t)((blk * 2 + (m == 0 ? 0 : 1)) * 4) * DFF + j0;
                        *(f32x4*)(eb) = pa_; *(f32x4*)(eb + DFF) = pb_; *(f32x4*)(eb + 2 * DFF) = acc[ai][0][m][n]; *(f32x4*)(eb + 3 * DFF) = acc[ai][1][m][n];
                    }
                }
            }
            __builtin_amdgcn_sched_barrier(0);
        }
    }
};
struct EpiMerge {
    static constexpr bool PERM = true;
    bf16_t* O; const bf16_t* Z;
    float* PARTM;
    __device__ __forceinline__ bool zero_after(const Unit& u) const { return u.seg == 3 || u.ks >= 0; }
    __device__ __forceinline__ void operator()(f32x4 (&acc)[2][2][4][2], const Unit& u, int wr, int wc, int fr, int fq) const {
        const bool indep = u.ks >= 0;
        if (u.seg == 2 && !indep) return;
        const int row0 = u.pm * BM + wr * 64 + fr, col0 = u.pn * BM + wc * 32 + 8 * fq;
        const bool plain = indep || u.seg == 3;
        const int sn = plain ? (u.seg < 2 ? u.seg : 2) : u.seg, sd = plain ? sn : u.seg + 1;
        const float dmask = plain ? 0.f : 1.f;
        const bf16_t* zn = Z + (size_t)row0 * IN_DIM + OFF_GATE + sn * DM + col0;
        const bf16_t* zd = Z + (size_t)row0 * IN_DIM + OFF_GATE + sd * DM + col0;
#define RAT(N, Dn) ((1.f + dmask * __expf(-(Dn))) * __builtin_amdgcn_rcpf(1.f + __expf(-(N))))
        u32x4 gn[2][2][2], gd[2][2][2];
#define MG_LOAD(B, S) do { _Pragma("unroll") for (int mm = 0; mm < 2; ++mm) _Pragma("unroll") for (int bj = 0; bj < 2; ++bj) { \
            const size_t o = (size_t)(((B) >> 1) * HALF + (((B) & 1) * 2 + mm) * 16) * IN_DIM + bj * HALF; \
            gn[S][mm][bj] = *(const u32x4*)(zn + o); gd[S][mm][bj] = *(const u32x4*)(zd + o); } } while (0)
#define MG_APPLY(B, S) do { _Pragma("unroll") for (int mm = 0; mm < 2; ++mm) _Pragma("unroll") for (int bj = 0; bj < 2; ++bj) { \
            f32x4& v0 = acc[(B) >> 1][bj][((B) & 1) * 2 + mm][0]; f32x4& v1 = acc[(B) >> 1][bj][((B) & 1) * 2 + mm][1]; \
            const u32x4 n_ = gn[S][mm][bj], d_ = gd[S][mm][bj]; \
            v0[0] *= RAT(lo_f(n_.x), lo_f(d_.x)); v0[1] *= RAT(hi_f(n_.x), hi_f(d_.x)); v0[2] *= RAT(lo_f(n_.y), lo_f(d_.y)); v0[3] *= RAT(hi_f(n_.y), hi_f(d_.y)); \
            v1[0] *= RAT(lo_f(n_.z), lo_f(d_.z)); v1[1] *= RAT(hi_f(n_.z), hi_f(d_.z)); v1[2] *= RAT(lo_f(n_.w), lo_f(d_.w)); v1[3] *= RAT(hi_f(n_.w), hi_f(d_.w)); } } while (0)
        MG_LOAD(0, 0); MG_LOAD(1, 1); __builtin_amdgcn_sched_barrier(0);
        MG_APPLY(0, 0); __builtin_amdgcn_sched_barrier(0);
        MG_LOAD(2, 0); __builtin_amdgcn_sched_barrier(0);
        MG_APPLY(1, 1); __builtin_amdgcn_sched_barrier(0);
        MG_LOAD(3, 1); __builtin_amdgcn_sched_barrier(0);
        MG_APPLY(2, 0); __builtin_amdgcn_sched_barrier(0);
        MG_APPLY(3, 1); __builtin_amdgcn_sched_barrier(0);
#undef MG_LOAD
#undef MG_APPLY
#undef RAT
        if (indep) {
            float* pb = PARTM + ((size_t)u.seg * TC + (size_t)(row0 - TL)) * DM + col0;
#pragma unroll
            for (int ai = 0; ai < 2; ++ai)
#pragma unroll
                for (int m = 0; m < 4; ++m)
#pragma unroll
                    for (int bj = 0; bj < 2; ++bj) { float* q = pb + (size_t)(ai * HALF + m * 16) * DM + bj * HALF; *(f32x4*)q = acc[ai][bj][m][0]; *(f32x4*)(q + 4) = acc[ai][bj][m][1]; }
        } else if (u.seg == 3) {
            bf16_t* ob = O + (size_t)row0 * DM + col0;
#pragma unroll
            for (int ai = 0; ai < 2; ++ai)
#pragma unroll
                for (int m = 0; m < 4; ++m)
#pragma unroll
                    for (int bj = 0; bj < 2; ++bj) { const f32x4 v0 = acc[ai][bj][m][0], v1 = acc[ai][bj][m][1];
                        u32x4 w; w.x = cvt_pk_bf16(v0[0], v0[1]); w.y = cvt_pk_bf16(v0[2], v0[3]); w.z = cvt_pk_bf16(v1[0], v1[1]); w.w = cvt_pk_bf16(v1[2], v1[3]);
                        *(u32x4*)(ob + (size_t)(ai * HALF + m * 16) * DM + bj * HALF) = w; }
        }
    }
};

#ifndef PG8_SP2
#define PG8_SP2 true
#endif
#ifndef PG8_ALIGN
#define PG8_ALIGN true
#endif
template <class Epi, bool ALIGN_EPI = PG8_ALIGN, bool SP2 = PG8_SP2>
__device__ __forceinline__ void gemm_phase(LAS unsigned char* lds, const int tid, const int K, const Order& S, const Epi& E) {
    const int wid = __builtin_amdgcn_readfirstlane(tid >> 6), lane = tid & 63, wr = wid >> 2, wc = wid & 3, fr = lane & 15, fq = lane >> 4;
    unsigned voffA[2], voffB[2];
#pragma unroll
    for (int i = 0; i < 2; ++i) { int R, C; stage_rc(tid * 16 + i * 8192, R, C); const int Rb = Epi::PERM ? ((R & ~31) + perm32(R & 31)) : R;
        voffA[i] = (unsigned)(R * K + C) * 2u; voffB[i] = (unsigned)(Rb * K + C) * 2u; }
    const size_t kstep = (size_t)(BK * 2);
    const size_t hstep = (size_t)HALF * K * 2;
    const unsigned ldsw = (unsigned)wid * 1024u;
    const int aoff = lds_byte(wr * 64 + fr, fq * 8), boff = lds_byte(wc * 32 + fr, fq * 8);
#define PG8_SA(b, h) (((b) * 2 + (h)) * HTB)
#define PG8_SB(b, h) ((4 + (b) * 2 + (h)) * HTB)
#define PG8_STAGE(bufoff, gbase, voff) do { _Pragma("unroll") for (int _i = 0; _i < 2; ++_i) \
        __builtin_amdgcn_global_load_lds((const unsigned*)((const char*)(gbase) + (voff)[_i]), (LAS unsigned*)(lds + (bufoff) + ldsw + _i * 8192), 16, 0, 0); } while (0)
#define PG8_LDA(dst, b, h) do { _Pragma("unroll") for (int m = 0; m < 4; ++m) _Pragma("unroll") for (int k = 0; k < 2; ++k) dst[m][k] = *(const LAS bf16x8*)(lds + PG8_SA(b, h) + aoff + m * 2048 + k * 1024); } while (0)
#define PG8_LDB(dst, b, h) do { _Pragma("unroll") for (int n = 0; n < 2; ++n) _Pragma("unroll") for (int k = 0; k < 2; ++k) dst[n][k] = *(const LAS bf16x8*)(lds + PG8_SB(b, h) + boff + n * 2048 + k * 1024); } while (0)
#define PG8_MMA(ai, bj, At, Bt) do { __builtin_amdgcn_s_setprio(1); _Pragma("unroll") for (int k = 0; k < 2; ++k) _Pragma("unroll") for (int m = 0; m < 4; ++m) _Pragma("unroll") for (int n = 0; n < 2; ++n) \
        acc[ai][bj][m][n] = __builtin_amdgcn_mfma_f32_16x16x32_bf16(Bt[n][k], At[m][k], acc[ai][bj][m][n], 0, 0, 0); __builtin_amdgcn_s_setprio(0); } while (0)
#define PG8_WAIT_V(n) asm volatile("s_waitcnt vmcnt(" #n ")" ::: "memory")
#define PG8_WAIT_L(n) asm volatile("s_waitcnt lgkmcnt(" #n ")" ::: "memory")
#define PG8_BAR __builtin_amdgcn_s_barrier()
#define PG8_SCHED __builtin_amdgcn_sched_barrier(0)
    Unit cur, nxt; int ui = 0;
    if (!S.next(0, cur)) return;
    f32x4 acc[2][2][4][2];
#pragma unroll
    for (int a = 0; a < 2; ++a)
#pragma unroll
        for (int b = 0; b < 2; ++b)
#pragma unroll
            for (int m = 0; m < 4; ++m)
#pragma unroll
                for (int n = 0; n < 2; ++n) acc[a][b][m][n] = (f32x4){0.f, 0.f, 0.f, 0.f};
    bf16x8 At[4][2], B0[2][2], B1[2][2];
    const char* cA = S.aptr(cur); const char* cB = S.bptr(cur);
    if constexpr (SP2) {
        PG8_STAGE(PG8_SB(0, 0), cB, voffB); PG8_STAGE(PG8_SB(0, 1), cB + hstep, voffB); PG8_STAGE(PG8_SA(0, 0), cA, voffA); PG8_STAGE(PG8_SA(0, 1), cA + hstep, voffA);
        if (wr == 1) PG8_BAR;
        PG8_WAIT_V(2); PG8_BAR;
        PG8_STAGE(PG8_SB(1, 0), cB + kstep, voffB); PG8_STAGE(PG8_SA(1, 0), cA + kstep, voffA); PG8_STAGE(PG8_SB(1, 1), cB + hstep + kstep, voffB);
        PG8_WAIT_V(6); PG8_BAR;
    } else {
    PG8_STAGE(PG8_SB(0, 0), cB, voffB); PG8_STAGE(PG8_SA(0, 0), cA, voffA); PG8_STAGE(PG8_SB(0, 1), cB + hstep, voffB); PG8_STAGE(PG8_SA(0, 1), cA + hstep, voffA);
    if (wr == 1) PG8_BAR;
    PG8_WAIT_V(4); PG8_BAR;
    PG8_STAGE(PG8_SB(1, 0), cB + kstep, voffB); PG8_STAGE(PG8_SA(1, 0), cA + kstep, voffA); PG8_STAGE(PG8_SB(1, 1), cB + hstep + kstep, voffB);
    PG8_WAIT_V(6); PG8_BAR;
    }
    for (;;) {
        const bool has_next = S.next(ui + 1, nxt);
        const char* nA = has_next ? S.aptr(nxt) : cA; const char* nB = has_next ? S.bptr(nxt) : cB;
        const int nt = S.nt(cur);
        for (int t = 0; t < nt; t += 2) {
            const bool last = (t == nt - 2);
            const char* a1 = cA + (size_t)(t + 1) * kstep;
            const char* a2 = last ? nA : cA + (size_t)(t + 2) * kstep; const char* b2 = last ? nB : cB + (size_t)(t + 2) * kstep;
            const char* a3 = a2 + kstep; const char* b3 = b2 + kstep;
            if (last && has_next) S.a_ready(nxt, tid);
            if constexpr (SP2) {
            PG8_LDB(B0, 0, 0); PG8_LDB(B1, 0, 1); PG8_SCHED; PG8_LDA(At, 0, 0); PG8_STAGE(PG8_SA(1, 1), a1 + hstep, voffA);
            PG8_WAIT_V(8); PG8_WAIT_L(0); PG8_BAR; PG8_MMA(0, 0, At, B0); PG8_MMA(0, 1, At, B1); PG8_BAR; PG8_SCHED;
            PG8_LDA(At, 0, 1); PG8_STAGE(PG8_SB(0, 0), b2, voffB); PG8_STAGE(PG8_SB(0, 1), b2 + hstep, voffB); PG8_STAGE(PG8_SA(0, 0), a2, voffA);
            PG8_WAIT_V(8); PG8_WAIT_L(0); PG8_BAR; PG8_MMA(1, 0, At, B0); PG8_MMA(1, 1, At, B1); PG8_BAR; PG8_SCHED;
            PG8_LDB(B0, 1, 0); PG8_LDB(B1, 1, 1); PG8_SCHED; PG8_LDA(At, 1, 0); PG8_STAGE(PG8_SA(0, 1), a2 + hstep, voffA);
            PG8_WAIT_V(8); PG8_WAIT_L(0); PG8_BAR; PG8_MMA(0, 0, At, B0); PG8_MMA(0, 1, At, B1); PG8_BAR; PG8_SCHED;
            PG8_LDA(At, 1, 1); PG8_STAGE(PG8_SB(1, 0), b3, voffB); PG8_STAGE(PG8_SB(1, 1), b3 + hstep, voffB); PG8_STAGE(PG8_SA(1, 0), a3, voffA);
            PG8_WAIT_V(8); PG8_WAIT_L(0); PG8_BAR; PG8_MMA(1, 0, At, B0); PG8_MMA(1, 1, At, B1); PG8_BAR; PG8_SCHED;
            } else {
            PG8_LDB(B0, 0, 0); PG8_SCHED; PG8_LDA(At, 0, 0); PG8_STAGE(PG8_SA(1, 1), a1 + hstep, voffA);
            PG8_WAIT_L(8); PG8_BAR; PG8_WAIT_L(0); PG8_MMA(0, 0, At, B0); PG8_BAR; PG8_SCHED;
            PG8_LDB(B1, 0, 1); PG8_STAGE(PG8_SB(0, 0), b2, voffB);
            PG8_BAR; PG8_WAIT_L(0); PG8_MMA(0, 1, At, B1); PG8_BAR;
            PG8_LDA(At, 0, 1); PG8_STAGE(PG8_SA(0, 0), a2, voffA);
            PG8_BAR; PG8_WAIT_L(0); PG8_MMA(1, 0, At, B0); PG8_BAR; PG8_SCHED;
            PG8_STAGE(PG8_SB(0, 1), b2 + hstep, voffB);
            PG8_WAIT_V(6); PG8_BAR; PG8_MMA(1, 1, At, B1); PG8_BAR;
            PG8_LDB(B0, 1, 0); PG8_SCHED; PG8_LDA(At, 1, 0); PG8_STAGE(PG8_SA(0, 1), a2 + hstep, voffA);
            PG8_WAIT_L(8); PG8_BAR; PG8_WAIT_L(0); PG8_MMA(0, 0, At, B0); PG8_BAR; PG8_SCHED;
            PG8_LDB(B1, 1, 1); PG8_STAGE(PG8_SB(1, 0), b3, voffB);
            PG8_BAR; PG8_WAIT_L(0); PG8_MMA(0, 1, At, B1); PG8_BAR;
            PG8_LDA(At, 1, 1); PG8_STAGE(PG8_SA(1, 0), a3, voffA);
            PG8_BAR; PG8_WAIT_L(0); PG8_MMA(1, 0, At, B0); PG8_BAR; PG8_SCHED;
            PG8_STAGE(PG8_SB(1, 1), b3 + hstep, voffB);
            PG8_WAIT_V(6); PG8_BAR; PG8_MMA(1, 1, At, B1); PG8_BAR;
            }
        }
        if constexpr (ALIGN_EPI) { if (wr == 0) PG8_BAR; }
        E(acc, cur, wr, wc, fr, fq);
        if (!has_next) break;
        if (E.zero_after(cur)) {
#pragma unroll
            for (int a = 0; a < 2; ++a)
#pragma unroll
                for (int b = 0; b < 2; ++b)
#pragma unroll
                    for (int m = 0; m < 4; ++m)
#pragma unroll
                        for (int n = 0; n < 2; ++n) acc[a][b][m][n] = (f32x4){0.f, 0.f, 0.f, 0.f};
        }
        cur = nxt; cA = nA; cB = nB; ++ui;
        if constexpr (ALIGN_EPI) { if (wr == 1) PG8_BAR; }
    }
    PG8_WAIT_V(0);
    if constexpr (!ALIGN_EPI) { if (wr == 0) PG8_BAR; }
    PG8_BAR;
#undef PG8_SA
#undef PG8_SB
#undef PG8_STAGE
#undef PG8_LDA
#undef PG8_LDB
#undef PG8_MMA
#undef PG8_WAIT_V
#undef PG8_WAIT_L
#undef PG8_BAR
#undef PG8_SCHED
}
}

#ifndef ATT_SDEPTH
#define ATT_SDEPTH 2
#endif
namespace att {
constexpr int D = 128, NW = 8, QBLK = 32, KVBLK = 64;
constexpr float SCALE = 0.088388347648318440f;
constexpr float THR = 8.f;
constexpr int LDQ = 2048, LDK = 512, LDO = 1024;
constexpr size_t SHM_V = KVBLK * D * 2, SHM_K = KVBLK * D * 2, SHM_ATTN = 2 * SHM_V + 2 * SHM_K + NW * 64 * 4;
#define KSWZ(row, colB) ((row) * 256 + ((colB) ^ (((row) & 7) << 4)))
#define SBAR() __builtin_amdgcn_sched_barrier(0)
__device__ __forceinline__ int crow(int r, int hi) { return (r & 3) + 8 * (r >> 2) + 4 * hi; }
__device__ __forceinline__ unsigned cvtpk(float lo, float hi) { unsigned r; asm volatile("v_cvt_pk_bf16_f32 %0, %1, %2" : "=v"(r) : "v"(lo), "v"(hi)); return r; }
__device__ __forceinline__ bf16x8 ld8(const bf16_t* p) { return *reinterpret_cast<const bf16x8*>(p); }

__device__ __forceinline__ void partialSM(f32x16& p0, f32x16& p1, float& m_reg, float& mn, float& alpha) {
  constexpr float C = SCALE * 1.4426950408889634f;
  float pmax = p0[0];
#pragma unroll
  for (int r = 1; r < 16; ++r) pmax = fmaxf(pmax, p0[r]);
#pragma unroll
  for (int r = 0; r < 16; ++r) pmax = fmaxf(pmax, p1[r]);
  { auto rr = __builtin_amdgcn_permlane32_swap(__float_as_uint(pmax), __float_as_uint(pmax), false, false);
    pmax = fmaxf(__uint_as_float(rr[0]), __uint_as_float(rr[1])); }
  if (__builtin_expect(__all(pmax - m_reg <= THR / SCALE), 1)) { mn = m_reg; alpha = 1.f; }
  else { mn = fmaxf(m_reg, pmax); alpha = __builtin_amdgcn_exp2f((m_reg - mn) * C); m_reg = mn; }
  float mnC = -mn * C;
#pragma unroll
  for (int r = 0; r < 16; ++r) p0[r] = fmaf(p0[r], C, mnC);
#pragma unroll
  for (int r = 0; r < 16; ++r) p1[r] = fmaf(p1[r], C, mnC);
#pragma unroll
  for (int r = 0; r < 16; ++r) p0[r] = __builtin_amdgcn_exp2f(p0[r]);
}
__device__ __forceinline__ void finishSM(f32x16& p0, f32x16& p1, float alpha, float& l_reg, bf16x8& pa0, bf16x8& pa1, bf16x8& pa2, bf16x8& pa3) {
#pragma unroll
  for (int r = 0; r < 16; ++r) p1[r] = __builtin_amdgcn_exp2f(p1[r]);
  float ps = 0;
#pragma unroll
  for (int r = 0; r < 16; ++r) ps += p0[r];
#pragma unroll
  for (int r = 0; r < 16; ++r) ps += p1[r];
  { auto rr = __builtin_amdgcn_permlane32_swap(__float_as_uint(ps), __float_as_uint(ps), false, false);
    ps = __uint_as_float(rr[0]) + __uint_as_float(rr[1]); }
  l_reg = l_reg * alpha + ps;
#define PK4(P, BASE, OUT) do { unsigned a0 = cvtpk(P[BASE + 0], P[BASE + 1]), a1 = cvtpk(P[BASE + 2], P[BASE + 3]);   \
    unsigned b0 = cvtpk(P[BASE + 4], P[BASE + 5]), b1 = cvtpk(P[BASE + 6], P[BASE + 7]);                              \
    auto r0 = __builtin_amdgcn_permlane32_swap(a0, b0, false, false); auto r1 = __builtin_amdgcn_permlane32_swap(a1, b1, false, false); \
    u32x4 w = {r0[0], r1[0], r0[1], r1[1]}; OUT = *reinterpret_cast<bf16x8*>(&w); } while (0)
  PK4(p0, 0, pa0); PK4(p0, 8, pa1); PK4(p1, 0, pa2); PK4(p1, 8, pa3);
#undef PK4
}
__device__ __forceinline__ void qkt(f32x16& p0, f32x16& p1, const bf16_t* Ks, const bf16x8* qr, int r32, int hi) {
  p0 = f32x16{}; p1 = f32x16{};
#pragma unroll
  for (int d0 = 0; d0 < 8; ++d0) { int cb = (d0 * 16 + hi * 8) * 2;
    bf16x8 b0 = *reinterpret_cast<const bf16x8*>((const char*)Ks + KSWZ(r32, cb));
    bf16x8 b1 = *reinterpret_cast<const bf16x8*>((const char*)Ks + KSWZ(32 + r32, cb));
    p0 = __builtin_amdgcn_mfma_f32_32x32x16_bf16(b0, qr[d0], p0, 0, 0, 0);
    p1 = __builtin_amdgcn_mfma_f32_32x32x16_bf16(b1, qr[d0], p1, 0, 0, 0); }
}
__device__ __forceinline__ int v_st(int k, int c) { const int kk = (k & ~0xC) | ((k & 4) << 1) | ((k & 8) >> 1); return ((kk >> 3) * 4 + (c >> 5)) * 512 + ((kk & 7) * 32 + (c & 31)) * 2; }
__device__ __forceinline__ int v_rd_base(int lane) { return ((lane & 3) << 3) | (((lane >> 2) & 3) << 6) | (((lane >> 4) & 1) << 5) | (((lane >> 5) & 1) << 8); }
constexpr int v_rd_off(int d0, int ks, int half) { return d0 * 512 + ks * 4096 + half * 2048; }
template <int OFF> __device__ __forceinline__ s16x4 tr_read(int vb) {
  s16x4 r; asm volatile("ds_read_b64_tr_b16 %0, %1 offset:%2" : "=&v"(r) : "v"(vb), "i"(OFF) : "memory"); return r;
}
template <int D0> __device__ __forceinline__ void pv_one(f32x16& od, int vb, bf16x8 pa0, bf16x8 pa1, bf16x8 pa2, bf16x8 pa3) {
  const s16x4 l0 = tr_read<v_rd_off(D0, 0, 0)>(vb), h0 = tr_read<v_rd_off(D0, 0, 1)>(vb), l1 = tr_read<v_rd_off(D0, 1, 0)>(vb), h1 = tr_read<v_rd_off(D0, 1, 1)>(vb);
  const s16x4 l2 = tr_read<v_rd_off(D0, 2, 0)>(vb), h2 = tr_read<v_rd_off(D0, 2, 1)>(vb), l3 = tr_read<v_rd_off(D0, 3, 0)>(vb), h3 = tr_read<v_rd_off(D0, 3, 1)>(vb);
  asm volatile("s_waitcnt lgkmcnt(0)" ::: "memory"); SBAR();
#define PK(L, H) (bf16x8){L[0], L[1], L[2], L[3], H[0], H[1], H[2], H[3]}
  od = __builtin_amdgcn_mfma_f32_32x32x16_bf16(pa0, PK(l0, h0), od, 0, 0, 0);
  od = __builtin_amdgcn_mfma_f32_32x32x16_bf16(pa1, PK(l1, h1), od, 0, 0, 0);
  od = __builtin_amdgcn_mfma_f32_32x32x16_bf16(pa2, PK(l2, h2), od, 0, 0, 0);
  od = __builtin_amdgcn_mfma_f32_32x32x16_bf16(pa3, PK(l3, h3), od, 0, 0, 0);
#undef PK
}
__device__ __forceinline__ void pv_d0(f32x16* o, int vb, bf16x8 pa0, bf16x8 pa1, bf16x8 pa2, bf16x8 pa3) {
  pv_one<0>(o[0], vb, pa0, pa1, pa2, pa3); pv_one<1>(o[1], vb, pa0, pa1, pa2, pa3); pv_one<2>(o[2], vb, pa0, pa1, pa2, pa3); pv_one<3>(o[3], vb, pa0, pa1, pa2, pa3);
}

__device__ __forceinline__ void attn_dense_body(const bf16_t* __restrict__ Qb, const bf16_t* __restrict__ Kh, const bf16_t* __restrict__ Vh,
                                                bf16_t* __restrict__ Ob, int seq, char* lds, const int tid) {
  constexpr int SDEPTH = ATT_SDEPTH;
  const int wid = tid >> 6, lane = tid & 63, r32 = lane & 31, hi = lane >> 5;
  bf16_t* V_lds = (bf16_t*)lds; bf16_t* K_lds = (bf16_t*)(lds + 2 * SHM_V);
  float* ws = (float*)(lds + 2 * SHM_V + 2 * SHM_K) + wid * 64; float* li_l = ws; float* al_l = ws + 32;
  float m_reg = -1e30f, l_reg = 0; f32x16 o[4] = {}; bf16x8 qr[8];
  const bf16_t* Qw = Qb + (long)(wid * QBLK + r32) * LDQ + hi * 8;
#pragma unroll
  for (int d0 = 0; d0 < 8; ++d0) qr[d0] = ld8(Qw + d0 * 16);
  const int sr = tid >> 4, sc = (tid & 15) * 8, vst0 = v_st(sr, sc), vst1 = v_st(32 + sr, sc);
  const int vb0 = (int)(uintptr_t)V_lds + v_rd_base(lane);
  struct { bf16x8 vs0, vs1, ks0, ks1; } sr_[SDEPTH];
  const unsigned so0 = (unsigned)(sr * LDK + sc) * 2u, so1 = so0 + 32u * LDK * 2u;
#define SLOAD(i, k0) do { const char* vb_ = (const char*)Vh + (size_t)(k0) * (LDK * 2); const char* kb_ = (const char*)Kh + (size_t)(k0) * (LDK * 2); \
    sr_[i].vs0 = *reinterpret_cast<const bf16x8*>(vb_ + so0); sr_[i].vs1 = *reinterpret_cast<const bf16x8*>(vb_ + so1); \
    sr_[i].ks0 = *reinterpret_cast<const bf16x8*>(kb_ + so0); sr_[i].ks1 = *reinterpret_cast<const bf16x8*>(kb_ + so1); } while (0)
#define SWRITE(b, i) do { *(bf16x8*)((char*)V_lds + (b) * SHM_V + vst0) = sr_[i].vs0;          \
    *(bf16x8*)((char*)V_lds + (b) * SHM_V + vst1) = sr_[i].vs1; int kc = sc * 2;               \
    *(bf16x8*)((char*)K_lds + (b) * SHM_K + KSWZ(sr, kc)) = sr_[i].ks0;                       \
    *(bf16x8*)((char*)K_lds + (b) * SHM_K + KSWZ(32 + sr, kc)) = sr_[i].ks1; } while (0)
#define SWAIT() do { if constexpr (SDEPTH == 2) asm volatile("s_waitcnt vmcnt(4)" ::: "memory"); else asm volatile("s_waitcnt vmcnt(0)" ::: "memory"); } while (0)
#define RESC(a) do { if (__any((a) < 1.f)) { if (hi == 0) al_l[r32] = (a); asm volatile("s_waitcnt lgkmcnt(0)" ::: "memory"); \
    _Pragma("unroll") for (int d = 0; d < 4; ++d) _Pragma("unroll") for (int r = 0; r < 16; ++r) o[d][r] *= al_l[crow(r, hi)]; } } while (0)
  f32x16 pA0, pA1, pB0, pB1; float mnA, mnB, alA, alB; bf16x8 pa0, pa1, pa2, pa3; const int NT = seq / KVBLK;
  constexpr int SE = 0, SO = SDEPTH - 1;
  SLOAD(SE, 0); asm volatile("s_waitcnt vmcnt(0)" ::: "memory"); SWRITE(0, SE); __syncthreads();
  qkt(pA0, pA1, K_lds, qr, r32, hi); partialSM(pA0, pA1, m_reg, mnA, alA);
  SLOAD(SO, KVBLK); if constexpr (SDEPTH == 2) { if (2 < NT) SLOAD(SE, 2 * KVBLK); }
  SWAIT(); SWRITE(1, SO); __syncthreads();
  for (int j = 1; j + 1 < NT; j += 2) {
    SBAR(); qkt(pB0, pB1, (bf16_t*)((char*)K_lds + SHM_K), qr, r32, hi);
    finishSM(pA0, pA1, alA, l_reg, pa0, pa1, pa2, pa3); SBAR();
    SLOAD(SO, (j + SDEPTH) * KVBLK); SBAR();
    pv_d0(o, vb0, pa0, pa1, pa2, pa3); partialSM(pB0, pB1, m_reg, mnB, alB);
    __syncthreads(); SWAIT(); SWRITE(0, SE);
    RESC(alB); __syncthreads();
    SBAR(); qkt(pA0, pA1, K_lds, qr, r32, hi);
    finishSM(pB0, pB1, alB, l_reg, pa0, pa1, pa2, pa3); SBAR();
    if (SDEPTH == 1 || j + 3 < NT) SLOAD(SE, (j + 1 + SDEPTH) * KVBLK); SBAR();
    pv_d0(o, vb0 + (int)SHM_V, pa0, pa1, pa2, pa3); partialSM(pA0, pA1, m_reg, mnA, alA);
    __syncthreads(); SWAIT(); SWRITE(1, SO);
    RESC(alA); __syncthreads();
  }
  SBAR(); qkt(pB0, pB1, (bf16_t*)((char*)K_lds + SHM_K), qr, r32, hi);
  finishSM(pA0, pA1, alA, l_reg, pa0, pa1, pa2, pa3); SBAR();
  pv_d0(o, vb0, pa0, pa1, pa2, pa3); partialSM(pB0, pB1, m_reg, mnB, alB);
  __syncthreads(); RESC(alB);
  finishSM(pB0, pB1, alB, l_reg, pa0, pa1, pa2, pa3); SBAR();
  pv_d0(o, vb0 + (int)SHM_V, pa0, pa1, pa2, pa3);
  if (hi == 0) li_l[r32] = l_reg; asm volatile("s_waitcnt lgkmcnt(0)" ::: "memory");
  float rli[16];
#pragma unroll
  for (int r = 0; r < 16; ++r) rli[r] = __builtin_amdgcn_rcpf(li_l[crow(r, hi)]);
  bf16_t* Ow = Ob + (long)(wid * QBLK) * LDO;
#pragma unroll
  for (int r = 0; r < 16; ++r) { int orow = crow(r, hi);
#pragma unroll
    for (int d0 = 0; d0 < 4; ++d0) Ow[(long)orow * LDO + d0 * 32 + r32] = f2bf(o[d0][r] * rli[r]); }
  __syncthreads();
#undef SLOAD
#undef SWRITE
#undef SWAIT
#undef RESC
}
}

#define XB_TMO      128
#define XB_XCNT(j)  (256  + 64 * (j))
#define XB_XSUB(j)  (1280 + 64 * (j))
#define XB_XGEN(j)  (2304 + 64 * (j))
#define XB_TOP      3328
#define XB_TOPGEN   3392
#define XCD_BAR_WORDS 3456
#define XB_SPIN_CAP (1u << 20)
__device__ __forceinline__ unsigned xb_ld(unsigned* p)              { return __hip_atomic_load(p, __ATOMIC_RELAXED, __HIP_MEMORY_SCOPE_AGENT); }
__device__ __forceinline__ unsigned xb_add(unsigned* p, unsigned v) { return __hip_atomic_fetch_add(p, v, __ATOMIC_RELAXED, __HIP_MEMORY_SCOPE_AGENT); }
__device__ __forceinline__ unsigned xb_xcc_id() { return (unsigned)__builtin_amdgcn_s_getreg((3 << 11) | 20) & 0xFu; }
#define XB_SPIN(cond, bar) do { unsigned _sp = 0; while (cond) { __builtin_amdgcn_s_sleep(1); \
    if ((++_sp & 255u) == 0u) { if (xb_ld(&(bar)[XB_TMO])) break; if (_sp > XB_SPIN_CAP) { atomicAdd(&(bar)[XB_TMO], 1u); break; } } } } while (0)
struct XcdBarrier { unsigned* bar; unsigned x; volatile LAS unsigned* st; int wave_s; };
__device__ __forceinline__ int lane_id_() { return (int)__builtin_amdgcn_mbcnt_hi(~0u, __builtin_amdgcn_mbcnt_lo(~0u, 0u)); }
__device__ __forceinline__ XcdBarrier xcd_barrier_post(unsigned* bar, volatile LAS unsigned* st, int wave_s) {
    XcdBarrier b; b.bar = bar; b.x = xb_xcc_id(); b.st = st; b.wave_s = wave_s;
    if (wave_s == 0 && lane_id_() == 0) (void)xb_add(&bar[XB_XCNT(b.x)], 1u);
    return b;
}
__device__ __forceinline__ void xcd_barrier_complete(unsigned* bar, unsigned x, unsigned& nloc, unsigned& nx) {
    const unsigned G = gridDim.x * gridDim.y * gridDim.z;
    unsigned sum, cnt, mine, sp = 0u;
    for (;;) {
        sum = 0u; cnt = 0u; mine = 0u;
#pragma unroll
        for (unsigned j = 0; j < 16; ++j) { const unsigned c = xb_ld(&bar[XB_XCNT(j)]); sum += c; cnt += (c > 0u) ? 1u : 0u; mine = (j == x) ? c : mine; }
        if (sum == G) break;
        __builtin_amdgcn_s_sleep(1);
        if ((++sp & 255u) == 0u) { if (xb_ld(&bar[XB_TMO])) break; if (sp > XB_SPIN_CAP) { atomicAdd(&bar[XB_TMO], 1u); break; } }
    }
    nloc = mine > 0u ? mine : 1u; nx = cnt > 0u ? cnt : 1u;
}
__device__ __forceinline__ void xcd_barrier(const XcdBarrier& b) {
    asm volatile("s_waitcnt vmcnt(0)" ::: "memory");
    __syncthreads();
    if (b.wave_s == 0 && lane_id_() == 0) {
        unsigned* bar = b.bar; asm volatile("" : "+s"(bar));
        __builtin_amdgcn_s_waitcnt(0);
        unsigned nloc = b.st[0], nx = b.st[1];
        if (nloc == 0u) { xcd_barrier_complete(bar, b.x, nloc, nx); b.st[0] = nloc; b.st[1] = nx; }
        const unsigned old = xb_add(&bar[XB_XSUB(b.x)], 1u);
        const unsigned gen = old / nloc;
        if (old + 1u == (gen + 1u) * nloc) {
            __builtin_amdgcn_fence(__ATOMIC_RELEASE, "agent");
            asm volatile("s_waitcnt vmcnt(0)" ::: "memory");
            const unsigned og = xb_add(&bar[XB_TOP], 1u);
            const unsigned tg = og / nx;
            if (og + 1u == (tg + 1u) * nx) xb_add(&bar[XB_TOPGEN], 1u);
            else XB_SPIN(xb_ld(&bar[XB_TOPGEN]) == tg, bar);
            __builtin_amdgcn_fence(__ATOMIC_ACQUIRE, "agent");
            xb_add(&bar[XB_XGEN(b.x)], 1u);
            asm volatile("s_waitcnt vmcnt(0)" ::: "memory");
        } else {
            XB_SPIN(xb_ld(&bar[XB_XGEN(b.x)]) == gen, bar);
            __builtin_amdgcn_fence(__ATOMIC_ACQUIRE, "agent");
            asm volatile("s_waitcnt vmcnt(0)" ::: "memory");
        }
    }
    __syncthreads();
}

typedef const __attribute__((address_space(4))) Params* KParams;
struct Ctx {
    KParams p; unsigned char* ws; int bid, G, tid, lane, wave;
    __device__ __forceinline__ bf16_t* bfp(size_t off) const { return (bf16_t*)(ws + off); }
    __device__ __forceinline__ float* fp(size_t off) const { return (float*)(ws + off); }
};

struct TTile { f32x4 v[4]; };
struct TRes { const float* src; bf16_t* dst; int N, ldt; };
__device__ __forceinline__ void ttile_load(TTile& T, const TRes& R, const int tid) {
    const int r = tid >> 4, c4 = tid & 15;
#pragma unroll
    for (int ps = 0; ps < 4; ++ps) T.v[ps] = __builtin_nontemporal_load((const f32x4*)(R.src + (size_t)(r + 32 * ps) * R.N + c4 * 4));
}
__device__ __forceinline__ void ttile_emit(const TTile& T, const TRes& R, float* tile, const int tid) {
    const int r = tid >> 4, c4 = tid & 15;
#pragma unroll
    for (int ps = 0; ps < 4; ++ps) { float* t = tile + (r + 32 * ps) * 65 + c4 * 4; t[0] = T.v[ps][0]; t[1] = T.v[ps][1]; t[2] = T.v[ps][2]; t[3] = T.v[ps][3]; }
    __syncthreads();
    const int kg = tid & 15, nn = tid >> 4;
#pragma unroll
    for (int ps = 0; ps < 2; ++ps) { const int n = nn + 32 * ps; const float* t = tile + (kg * 8) * 65 + n;
        u32x4 w; w.x = cvt_pk_bf16(t[0], t[65]); w.y = cvt_pk_bf16(t[130], t[195]); w.z = cvt_pk_bf16(t[260], t[325]); w.w = cvt_pk_bf16(t[390], t[455]);
        *(u32x4*)(R.dst + (size_t)n * R.ldt + kg * 8) = w; }
    __syncthreads();
}
constexpr int WT_TILES = 3584 + 4 * 256 + 512 + 2752 + 1376;
__device__ __forceinline__ TRes tresolve(const Ctx& c, int l, int g) {
    const KParams pk = c.p;
    const float* src; bf16_t* dst; int N, ldt, t = g; bool isup = false;
    if (t < 3584) { src = pk->in[7] + (size_t)l * DM * IN_DIM; N = IN_DIM; ldt = DM; dst = c.bfp(WS_WIN + l * SZ_WIN); }
    else if ((t -= 3584) < 1024) { const int w = t >> 8; t &= 255; N = DM; ldt = 1024; dst = c.bfp(WS_WM + l * SZ_WM + (size_t)w * (SZ_WM / 4));
        src = w == 0 ? pk->in[14] + (size_t)l * 1024 * DM : w == 1 ? pk->in[15] + (size_t)l * 1024 * DM : pk->in[16] + (size_t)l * DM * DM + (size_t)(w - 2) * 1024 * DM; }
    else if ((t -= 1024) < 512) { src = pk->in[17] + (size_t)l * DM * DM; N = DM; ldt = DM; dst = c.bfp(WS_WO + l * SZ_WO); }
    else if ((t -= 512) < 2752) { src = pk->in[19] + (size_t)l * DM * DFF2; N = DFF2; ldt = DM; dst = c.bfp(WS_WUP + l * SZ_WUP); isup = true; }
    else { t -= 2752; src = pk->in[21] + (size_t)l * DFF * DM; N = DM; ldt = DFF; dst = c.bfp(WS_WDN + l * SZ_WDN); }
    const int nnt = N >> 6, kt = t / nnt, ntl = t - kt * nnt;
    int drow = ntl * 64;
    if (isup) { const int n0 = ntl * 64, bj = n0 >= DFF ? 1 : 0, jrel = n0 - bj * DFF; drow = (jrel >> 7) * 256 + bj * 128 + (jrel & 127); }
    TRes R; R.src = src + (size_t)(kt * 128) * N + ntl * 64; R.dst = dst + (size_t)drow * ldt + kt * 128; R.N = N; R.ldt = ldt; return R;
}
__device__ void weights_range(const Ctx& c, int l, int g0, int stride, int gend, int maxn, float* lds) {
    TTile T0, T1; TRes R0, R1;
    int g = g0, left = maxn;
    bool v0 = g < gend && left > 0;
    if (v0) { R0 = tresolve(c, l, g); ttile_load(T0, R0, c.tid); }
    while (v0) {
        const int g1 = g + stride, g2 = g1 + stride;
        const bool v1 = g1 < gend && left > 1, v2 = v1 && g2 < gend && left > 2;
        if (v1) { R1 = tresolve(c, l, g1); ttile_load(T1, R1, c.tid); }
        ttile_emit(T0, R0, lds, c.tid);
        if (v2) { R0 = tresolve(c, l, g2); ttile_load(T0, R0, c.tid); }
        if (v1) ttile_emit(T1, R1, lds, c.tid);
        g = g2; left -= 2; v0 = v2;
    }
}
constexpr int WTA_N = 28, WTB_N = 16, WTC_N = 25;
constexpr int WTA_END = 32 * WTA_N, WTB_END = WTA_END + 128 * WTB_N, WTC_END = WTB_END + 244 * WTC_N;
static_assert(WTC_END <= WT_TILES, "tail budgets exceed the tile list");

__device__ void phase_prep(const Ctx& c, float* lds) {
    const KParams pk = c.p;
    {
        float* s = lds; float* red = lds + 5 * DM;
        for (int i = c.tid; i < 5 * DM; i += NTHR) { const int r = i / DM, k = i % DM; const float v = r < 4 ? pk->in[1][r * DM + k] : pk->in[3][k]; s[i] = v / (1.f + __expf(-v)); }
        __syncthreads();
        const int kg = c.tid >> 5, l32 = c.tid & 31;
        for (int unit = c.bid; unit < 256; unit += c.G) {
            const int l = unit >> 7, n0 = (unit & 127) * 96;
            const float* W = pk->in[4] + (size_t)l * DM * MODW + n0 + l32;
            float a0[5] = {0.f, 0.f, 0.f, 0.f, 0.f}, a1[5] = {0.f, 0.f, 0.f, 0.f, 0.f}, a2[5] = {0.f, 0.f, 0.f, 0.f, 0.f};
            const int kb = kg * 128;
#pragma unroll 8
            for (int k = kb; k < kb + 128; ++k) { const float* wr_ = W + (size_t)k * MODW; const float w0 = wr_[0], w1 = wr_[32], w2 = wr_[64];
#pragma unroll
                for (int r = 0; r < 5; ++r) { const float sv = s[r * DM + k]; a0[r] += sv * w0; a1[r] += sv * w1; a2[r] += sv * w2; } }
#pragma unroll
            for (int r = 0; r < 5; ++r) { float* rp = red + (kg * 5 + r) * 96 + l32; rp[0] = a0[r]; rp[32] = a1[r]; rp[64] = a2[r]; }
            __syncthreads();
            for (int i = c.tid; i < 5 * 96; i += NTHR) { const int r = i / 96, ci = i - r * 96; float sum = 0.f;
#pragma unroll
                for (int w = 0; w < 16; ++w) sum += red[(w * 5 + r) * 96 + ci];
                c.fp(WS_MOD)[(size_t)(l * 5 + r) * MODW + n0 + ci] = sum + pk->in[5][l * MODW + n0 + ci]; }
            __syncthreads();
        }
    }
    for (int i = c.bid * NTHR + c.tid; i < SEQL * 64; i += c.G * NTHR) { const int t = i >> 6, ax = (i >> 5) & 1, f = i & 31;
        const float inv_freq = exp2f(-(float)f * (13.287712379549449f / 32.f));
        const float ang = (ax == 0 ? (float)(t >> 6) : (float)(t & 63)) * inv_freq;
        f32x2 cs2; cs2.x = cosf(ang); cs2.y = sinf(ang); *(f32x2*)(c.fp(WS_ROPE) + (size_t)i * 2) = cs2; }
    weights_range(c, 0, c.bid, c.G, WT_TILES, 1 << 30, lds);
}

__device__ __forceinline__ void load_row32(f32x4 (&v)[8], const void* base, bool isf32, size_t rowoff, int lane) {
    if (isf32) { const float* p = (const float*)base + rowoff + lane * 8;
#pragma unroll
        for (int i = 0; i < 4; ++i) { v[2 * i] = *(const f32x4*)(p + i * 512); v[2 * i + 1] = *(const f32x4*)(p + i * 512 + 4); } }
    else { const bf16_t* p = (const bf16_t*)base + rowoff + lane * 8;
#pragma unroll
        for (int i = 0; i < 4; ++i) { const u32x4 xb = *(const u32x4*)(p + i * 512);
            v[2 * i] = (f32x4){lo_f(xb.x), hi_f(xb.x), lo_f(xb.y), hi_f(xb.y)}; v[2 * i + 1] = (f32x4){lo_f(xb.z), hi_f(xb.z), lo_f(xb.w), hi_f(xb.w)}; } }
}
__device__ void phase_norm(const Ctx& c, const void* xlat, bool lat_f32, const void* xctx, bool ctx_f32, const float* __restrict__ g, const float* __restrict__ mod, int sh_off, int sc_off,
                           bf16_t* __restrict__ dst, int nrows, const float* part) {
    bf16_t* XW = c.bfp(WS_XW);
    for (int row = c.bid * 8 + c.wave; row < nrows; row += c.G * 8) {
        f32x4 v[8];
        if (row < TL) load_row32(v, xlat, lat_f32, (size_t)row * DM, c.lane); else load_row32(v, xctx, ctx_f32, (size_t)(row - TL) * DM, c.lane);
        if (part != nullptr && row >= TL) {
            const float* pr = part + (size_t)(row - TL) * DM + c.lane * 8; bf16_t* xo = XW + (size_t)row * DM + c.lane * 8;
#pragma unroll
            for (int i = 0; i < 4; ++i) {
#pragma unroll
                for (int sp = 0; sp < 8; ++sp) { v[2 * i] += *(const f32x4*)(pr + (size_t)sp * TC * DM + i * 512); v[2 * i + 1] += *(const f32x4*)(pr + (size_t)sp * TC * DM + i * 512 + 4); }
                u32x4 w; w.x = cvt_pk_bf16(v[2 * i][0], v[2 * i][1]); w.y = cvt_pk_bf16(v[2 * i][2], v[2 * i][3]); w.z = cvt_pk_bf16(v[2 * i + 1][0], v[2 * i + 1][1]); w.w = cvt_pk_bf16(v[2 * i + 1][2], v[2 * i + 1][3]);
                *(u32x4*)(xo + i * 512) = w;
                __builtin_amdgcn_sched_barrier(0); }
        }
        float ss = 0.f;
#pragma unroll
        for (int i = 0; i < 8; ++i) ss += v[i][0] * v[i][0] + v[i][1] * v[i][1] + v[i][2] * v[i][2] + v[i][3] * v[i][3];
        ss = wave_sum(ss, c.lane);
        const float rstd = rsqrtf(ss * (1.f / DM) + EPS);
        const int r = row < TL ? (row >> 11) : 4;
        const float* md = mod + (size_t)r * MODW + c.lane * 8;
#pragma unroll
        for (int i = 0; i < 4; ++i) { const int cc = i * 512;
            f32x4 y[2];
#pragma unroll
            for (int h = 0; h < 2; ++h) { const f32x4 gg = *(const f32x4*)(g + cc + c.lane * 8 + 4 * h), sh = *(const f32x4*)(md + sh_off + cc + 4 * h), sc = *(const f32x4*)(md + sc_off + cc + 4 * h);
#pragma unroll
                for (int j = 0; j < 4; ++j) y[h][j] = v[2 * i + h][j] * rstd * gg[j] * (1.f + sc[j]) + sh[j]; }
            u32x4 w; w.x = cvt_pk_bf16(y[0][0], y[0][1]); w.y = cvt_pk_bf16(y[0][2], y[0][3]); w.z = cvt_pk_bf16(y[1][0], y[1][1]); w.w = cvt_pk_bf16(y[1][2], y[1][3]);
            *(u32x4*)(dst + (size_t)row * DM + cc + c.lane * 8) = w; }
    }
}

__device__ void phase_final(const Ctx& c) {
    const bf16_t* xw = c.bfp(WS_XW); const float* g = c.p->in[22]; float* out = c.p->out;
    for (int row = c.bid * 8 + c.wave; row < TL; row += c.G * 8) {
        f32x4 v[8]; load_row32(v, xw, false, (size_t)row * DM, c.lane);
        float ss = 0.f;
#pragma unroll
        for (int i = 0; i < 8; ++i) ss += v[i][0] * v[i][0] + v[i][1] * v[i][1] + v[i][2] * v[i][2] + v[i][3] * v[i][3];
        ss = wave_sum(ss, c.lane);
        const float rstd = rsqrtf(ss * (1.f / DM) + EPS);
#pragma unroll
        for (int i = 0; i < 8; ++i) { const int cc = (i >> 1) * 512 + c.lane * 8 + 4 * (i & 1); const f32x4 gg = *(const f32x4*)(g + cc); f32x4 y;
#pragma unroll
            for (int j = 0; j < 4; ++j) y[j] = v[i][j] * rstd * gg[j];
            *(f32x4*)(out + (size_t)row * DM + cc) = y; }
    }
}

__device__ __forceinline__ u32x4 kv_share8(const float* p) {
    f32x4 a = *(const f32x4*)p, b = *(const f32x4*)(p + 4);
#pragma unroll
    for (int sp = 1; sp < 8; ++sp) { a += *(const f32x4*)(p + (size_t)sp * TC * 1024); b += *(const f32x4*)(p + (size_t)sp * TC * 1024 + 4); }
    u32x4 w; w.x = cvt_pk_bf16(a[0], a[1]); w.y = cvt_pk_bf16(a[2], a[3]); w.z = cvt_pk_bf16(b[0], b[1]); w.w = cvt_pk_bf16(b[2], b[3]); return w;
}

__device__ void phase_post(const Ctx& c, int l, bool ctx_full) {
    const KParams pk = c.p;
    const bf16_t* Z = c.bfp(WS_Z);
    bf16_t* Qo = c.bfp(WS_Q); bf16_t* Ko = c.bfp(WS_K); bf16_t* Vo = c.bfp(WS_V); bf16_t* VN = c.bfp(WS_VN);
    bf16_t* AM0 = c.bfp(WS_AM); bf16_t* AM1 = c.bfp(WS_AM + (size_t)TT * 1024 * 2);
    const int l16 = c.lane & 15, grp = c.lane >> 4, axis = l16 >> 3, fb = (l16 & 3) * 8;
    const bool firsth = (l16 & 4) == 0;
    float gqo[8], gqp[8], gko[8], gkp[8];
#pragma unroll
    for (int i = 0; i < 8; ++i) { gqo[i] = pk->in[8][l * 128 + 8 * l16 + i]; gqp[i] = pk->in[8][l * 128 + 8 * (l16 ^ 4) + i]; gko[i] = pk->in[9][l * 128 + 8 * l16 + i]; gkp[i] = pk->in[9][l * 128 + 8 * (l16 ^ 4) + i]; }
    const float* rope = c.fp(WS_ROPE);
    const float* kvp = c.fp(WS_AM + (size_t)2 * TT * 1024 * 2);
    const float* gv = pk->in[12] + l * 1024; const float* wsc = pk->in[13] + (size_t)l * 3 * 1024;
    for (int row = c.bid * 8 + c.wave; row < TT; row += c.G * 8) {
        const bool lat = row < TL; int b, t, slen;
        if (lat) { b = row >> 11; t = row & 2047; slen = SEQL; } else { b = (row - TL) >> 8; t = (row - TL) & 255; slen = CTXL; }
        const bool full = lat || ctx_full;
        const bf16_t* zr = Z + (size_t)row * IN_DIM;
        float cs[8], sn[8];
        if (lat) { const float* rp = rope + ((size_t)t * 64 + axis * 32 + fb) * 2;
#pragma unroll
            for (int i = 0; i < 4; ++i) { const f32x4 v = *(const f32x4*)(rp + i * 4); cs[2 * i] = v[0]; sn[2 * i] = v[1]; cs[2 * i + 1] = v[2]; sn[2 * i + 1] = v[3]; } }
        else {
#pragma unroll
            for (int i = 0; i < 8; ++i) { cs[i] = 1.f; sn[i] = 0.f; } }
        const size_t kvrow = (size_t)b * SKV + (lat ? t : SEQL + t);
        for (int p = full ? 0 : 4; p < 5; ++p) {
            const int hd = 4 * p + grp;
            u32x4 raw;
            if (full) raw = *(const u32x4*)(zr + hd * 128 + 8 * l16);
            else raw = kv_share8(kvp + (size_t)(row - TL) * 1024 + grp * 128 + 8 * l16);
            float own[8] = {lo_f(raw.x), hi_f(raw.x), lo_f(raw.y), hi_f(raw.y), lo_f(raw.z), hi_f(raw.z), lo_f(raw.w), hi_f(raw.w)};
            float ss = 0.f;
#pragma unroll
            for (int i = 0; i < 8; ++i) ss += own[i] * own[i];
#pragma unroll
            for (int o = 8; o; o >>= 1) ss += __int_as_float(__builtin_amdgcn_ds_bpermute((c.lane ^ o) << 2, __float_as_int(ss)));
            const float rstd = rsqrtf(ss * (1.f / 128.f) + EPS);
            u32x4 pr;
            pr.x = (unsigned)__builtin_amdgcn_ds_bpermute((c.lane ^ 4) << 2, (int)raw.x); pr.y = (unsigned)__builtin_amdgcn_ds_bpermute((c.lane ^ 4) << 2, (int)raw.y);
            pr.z = (unsigned)__builtin_amdgcn_ds_bpermute((c.lane ^ 4) << 2, (int)raw.z); pr.w = (unsigned)__builtin_amdgcn_ds_bpermute((c.lane ^ 4) << 2, (int)raw.w);
            const float par[8] = {lo_f(pr.x), hi_f(pr.x), lo_f(pr.y), hi_f(pr.y), lo_f(pr.z), hi_f(pr.z), lo_f(pr.w), hi_f(pr.w)};
            float o8[8];
#pragma unroll
            for (int i = 0; i < 8; ++i) { const float on = own[i] * rstd * (p < 4 ? gqo[i] : gko[i]), pn = par[i] * rstd * (p < 4 ? gqp[i] : gkp[i]);
                o8[i] = firsth ? on * cs[i] - pn * sn[i] : on * cs[i] + pn * sn[i]; }
            u32x4 w; w.x = cvt_pk_bf16(o8[0], o8[1]); w.y = cvt_pk_bf16(o8[2], o8[3]); w.z = cvt_pk_bf16(o8[4], o8[5]); w.w = cvt_pk_bf16(o8[6], o8[7]);
            if (p < 4) *(u32x4*)(Qo + (size_t)row * DM + hd * 128 + 8 * l16) = w;
            else *(u32x4*)(Ko + kvrow * 512 + grp * 128 + 8 * l16) = w;
        }
        if (!full) *(u32x4*)(Vo + kvrow * 512 + c.lane * 8) = kv_share8(kvp + (size_t)(row - TL) * 1024 + 512 + c.lane * 8);
        if (full) {
            float fv[16]; float ss = 0.f;
#pragma unroll
            for (int i = 0; i < 2; ++i) { const int cc = i * 512 + c.lane * 8;
                const u32x4 zv = *(const u32x4*)(zr + OFF_GV + cc);
                fv[i * 8 + 0] = gelu_tanh(lo_f(zv.x)); fv[i * 8 + 1] = gelu_tanh(hi_f(zv.x)); fv[i * 8 + 2] = gelu_tanh(lo_f(zv.y)); fv[i * 8 + 3] = gelu_tanh(hi_f(zv.y));
                fv[i * 8 + 4] = gelu_tanh(lo_f(zv.z)); fv[i * 8 + 5] = gelu_tanh(hi_f(zv.z)); fv[i * 8 + 6] = gelu_tanh(lo_f(zv.w)); fv[i * 8 + 7] = gelu_tanh(hi_f(zv.w));
#pragma unroll
                for (int j = 0; j < 8; ++j) ss += fv[i * 8 + j] * fv[i * 8 + j]; }
            ss = wave_sum(ss, c.lane); const float rstd = rsqrtf(ss * (1.f / 1024.f) + EPS);
#pragma unroll
            for (int i = 0; i < 2; ++i) { const int cc = i * 512 + c.lane * 8;
                const f32x4 g0 = *(const f32x4*)(gv + cc), g1 = *(const f32x4*)(gv + cc + 4);
                u32x4 w;
                w.x = cvt_pk_bf16(fv[i * 8 + 0] * rstd * g0[0], fv[i * 8 + 1] * rstd * g0[1]); w.y = cvt_pk_bf16(fv[i * 8 + 2] * rstd * g0[2], fv[i * 8 + 3] * rstd * g0[3]);
                w.z = cvt_pk_bf16(fv[i * 8 + 4] * rstd * g1[0], fv[i * 8 + 5] * rstd * g1[1]); w.w = cvt_pk_bf16(fv[i * 8 + 6] * rstd * g1[2], fv[i * 8 + 7] * rstd * g1[3]);
                *(u32x4*)(VN + (size_t)row * 1024 + cc) = w; }
#pragma unroll
            for (int i = 0; i < 2; ++i) { const int cc = i * 512 + c.lane * 8;
                float a[8] = {0.f, 0.f, 0.f, 0.f, 0.f, 0.f, 0.f, 0.f};
#pragma unroll
                for (int k = 0; k < 3; ++k) { const int tt = t + k - 1;
                    if (tt >= 0 && tt < slen) { const bf16_t* z2 = zr + (ptrdiff_t)(k - 1) * IN_DIM;
                        const u32x4 cg = *(const u32x4*)(z2 + OFF_CC + cc), hh = *(const u32x4*)(z2 + OFF_CH + cc);
                        const f32x4 w0 = *(const f32x4*)(wsc + k * 1024 + cc), w1 = *(const f32x4*)(wsc + k * 1024 + cc + 4);
                        a[0] += w0[0] * lo_f(cg.x) * lo_f(hh.x); a[1] += w0[1] * hi_f(cg.x) * hi_f(hh.x); a[2] += w0[2] * lo_f(cg.y) * lo_f(hh.y); a[3] += w0[3] * hi_f(cg.y) * hi_f(hh.y);
                        a[4] += w1[0] * lo_f(cg.z) * lo_f(hh.z); a[5] += w1[1] * hi_f(cg.z) * hi_f(hh.z); a[6] += w1[2] * lo_f(cg.w) * lo_f(hh.w); a[7] += w1[3] * hi_f(cg.w) * hi_f(hh.w); } }
                const u32x4 bg = *(const u32x4*)(zr + OFF_CB + cc);
                u32x4 w;
                w.x = cvt_pk_bf16(a[0] * lo_f(bg.x), a[1] * hi_f(bg.x)); w.y = cvt_pk_bf16(a[2] * lo_f(bg.y), a[3] * hi_f(bg.y));
                w.z = cvt_pk_bf16(a[4] * lo_f(bg.z), a[5] * hi_f(bg.z)); w.w = cvt_pk_bf16(a[6] * lo_f(bg.w), a[7] * hi_f(bg.w));
                *(u32x4*)(AM1 + (size_t)row * 1024 + cc) = w; }
        }
    }
}

__device__ void gmlp_unit(const Ctx& c, int tid, int l, int ch, int g, unsigned short* T) {
    const KParams pk = c.p;
    const int lane = tid & 63, wave = tid >> 6;
    const int r32 = lane & 31, hi = lane >> 5, pblk = wave >> 1, cb0 = (wave & 1) * 2;
    const float* wsr = pk->in[10] + ((size_t)(l * 8 + g) * 128 + pblk * 32 + r32) * 128 + hi * 8;
    const bf16_t* vn = c.bfp(WS_VN) + (size_t)(ch * 128) * 1024 + g * 128;
    bf16_t* AM0 = c.bfp(WS_AM);
    {
        const int q = tid >> 4, c8 = (tid & 15) * 8;
        u32x4 v[4];
#pragma unroll
        for (int ps = 0; ps < 4; ++ps) v[ps] = *(const u32x4*)(vn + (size_t)(q + 32 * ps) * 1024 + c8);
#pragma unroll
        for (int ps = 0; ps < 4; ++ps) { unsigned short* d = T + (q + 32 * ps) * 132 + c8; *(u32x2*)d = (u32x2){v[ps].x, v[ps].y}; *(u32x2*)(d + 4) = (u32x2){v[ps].z, v[ps].w}; }
    }
    bf16x8 af[8];
#pragma unroll
    for (int ks = 0; ks < 8; ++ks) { const f32x4 a0 = *(const f32x4*)(wsr + ks * 16), a1 = *(const f32x4*)(wsr + ks * 16 + 4);
        u32x4 aw; aw.x = cvt_pk_bf16(a0[0], a0[1]); aw.y = cvt_pk_bf16(a0[2], a0[3]); aw.z = cvt_pk_bf16(a1[0], a1[1]); aw.w = cvt_pk_bf16(a1[2], a1[3]);
        af[ks] = *reinterpret_cast<const bf16x8*>(&aw); }
    __syncthreads();
    f32x16 acc0 = {}, acc1 = {};
    const unsigned short* tb = T + (hi * 8) * 132 + cb0 * 32 + r32;
#pragma unroll
    for (int ks = 0; ks < 8; ++ks) {
        bf16x8 b0, b1;
#pragma unroll
        for (int j = 0; j < 8; ++j) { b0[j] = (short)tb[(ks * 16 + j) * 132]; b1[j] = (short)tb[(ks * 16 + j) * 132 + 32]; }
        acc0 = __builtin_amdgcn_mfma_f32_32x32x16_bf16(af[ks], b0, acc0, 0, 0, 0);
        acc1 = __builtin_amdgcn_mfma_f32_32x32x16_bf16(af[ks], b1, acc1, 0, 0, 0); }
#pragma unroll
    for (int r = 0; r < 16; ++r) { const int prow = pblk * 32 + att::crow(r, hi); const size_t t = (size_t)ch * 128 + prow;
        const float bias = pk->in[11][(l * 8 + g) * 128 + prow];
        bf16_t* up = AM0 + t * 1024 + g * 128 + cb0 * 32 + r32;
        up[0] = f2bf(bf2f(up[0]) * (acc0[r] + bias)); up[32] = f2bf(bf2f(up[32]) * (acc1[r] + bias)); }
    __syncthreads();
}

__device__ void phase_attn(const Ctx& c, int l, bool with_ctx, char* lds, bool skip_gmlp) {
    const bf16_t* Qb = c.bfp(WS_Q); const bf16_t* Kb = c.bfp(WS_K); const bf16_t* Vb = c.bfp(WS_V); bf16_t* AM = c.bfp(WS_AM);
    const int nun = with_ctx ? 576 : 512;
    for (int i = 0; ; ++i) {
        const int L = i * c.G + c.bid; if (L >= nun) break;
        int b, h, seq; size_t qrow, kvrow;
        if (L < 512) {
            if (c.G == 256) { const int xcd = c.bid & 7, slot = c.bid >> 3, grp = i * 8 + xcd; b = grp >> 2; h = (grp & 3) * 4 + (slot >> 3); qrow = (size_t)b * SEQL + (slot & 7) * 256; }
            else { b = L >> 7; h = (L >> 3) & 15; qrow = (size_t)b * SEQL + (L & 7) * 256; }
            kvrow = (size_t)b * SKV; seq = SKV;
        } else { const int u = L - 512; b = u >> 4; h = u & 15; qrow = (size_t)TL + b * CTXL; kvrow = (size_t)b * SKV + SEQL; seq = CTXL; }
        const int kvh = h >> 2;
        att::attn_dense_body(Qb + qrow * DM + h * 128, Kb + kvrow * 512 + kvh * 128, Vb + kvrow * 512 + kvh * 128,
                             AM + (size_t)(2 + (h >> 3)) * TT * 1024 + qrow * 1024 + (h & 7) * 128, seq, lds, c.tid);
    }
    if (skip_gmlp) return;
    const int nch = with_ctx ? 72 : 64;
#ifndef NO_GMLP
    int t2 = c.tid; asm volatile("" : "+v"(t2));
    for (int u = c.bid; u < nch * 8; u += c.G) gmlp_unit(c, t2, l, u >> 3, u & 7, (unsigned short*)lds);
#endif
}

__device__ void phase_ffnfix(const Ctx& c, int l, int nrows) {
    bf16_t* Gb = c.bfp(WS_AM); const float* ED = c.fp(WS_EDGE);
    const float* wcv = c.p->in[20] + (size_t)l * 3 * DFF2;
    constexpr int NCH = DFF / 8;
    const int total = (nrows / 64) * 2 * NCH;
    for (int idx = c.bid * NTHR + c.tid; idx < total; idx += c.G * NTHR) {
        const int be = idx / NCH, chn = idx - be * NCH, j = chn * 8, blk = be >> 1, e = be & 1;
        const int row = blk * 64 + (e ? 63 : 0);
        int t, slen; if (row < TL) { t = row & (SEQL - 1); slen = SEQL; } else { t = (row - TL) & (CTXL - 1); slen = CTXL; }
        const bool nbv = e ? (t + 1 < slen) : (t > 0);
        const float* eb = ED + (size_t)(be * 4) * DFF + j;
        const float* nb = ED + (size_t)(((e ? blk + 1 : blk - 1) * 2 + (e ? 0 : 1)) * 4 + 2) * DFF + j;
        const float* wk = wcv + (size_t)(e ? 2 : 0) * DFF2 + j;
        f32x4 ca0 = *(const f32x4*)eb, ca1 = *(const f32x4*)(eb + 4), cb0 = *(const f32x4*)(eb + DFF), cb1 = *(const f32x4*)(eb + DFF + 4);
        if (nbv) { ca0 += *(const f32x4*)wk * *(const f32x4*)nb; ca1 += *(const f32x4*)(wk + 4) * *(const f32x4*)(nb + 4);
                   cb0 += *(const f32x4*)(wk + DFF) * *(const f32x4*)(nb + DFF); cb1 += *(const f32x4*)(wk + DFF + 4) * *(const f32x4*)(nb + DFF + 4); }
        float y[8];
#pragma unroll
        for (int q = 0; q < 4; ++q) { y[q] = ca0[q] * sigmoidf_(ca0[q]) * cb0[q]; y[4 + q] = ca1[q] * sigmoidf_(ca1[q]) * cb1[q]; }
        u32x4 w; w.x = cvt_pk_bf16(y[0], y[1]); w.y = cvt_pk_bf16(y[2], y[3]); w.z = cvt_pk_bf16(y[4], y[5]); w.w = cvt_pk_bf16(y[6], y[7]);
        *(u32x4*)(Gb + (size_t)row * DFF + j) = w;
    }
}

constexpr int PH_PER_LAYER = 10, NPH = 1 + 2 * PH_PER_LAYER + 1;
#ifndef PH_MASK
#define PH_MASK 0xFFFF
#endif
#define PH_EN(n) ((PH_MASK >> (n)) & 1)

__device__ void ctx_m_convert(const Ctx& c, unsigned* cnt) {
    const float* ps = c.fp(WS_Q); bf16_t* mh = c.bfp(WS_H) + (size_t)TL * DM;
    for (int i = c.bid * NTHR + c.tid; i < TC * DM / 8; i += c.G * NTHR) {
        const float* q = ps + (size_t)i * 8;
        f32x4 a = *(const f32x4*)q, b = *(const f32x4*)(q + 4);
#pragma unroll
        for (int sg = 1; sg < 4; ++sg) { a += *(const f32x4*)(q + (size_t)sg * TC * DM); b += *(const f32x4*)(q + (size_t)sg * TC * DM + 4); }
        u32x4 w; w.x = cvt_pk_bf16(a[0], a[1]); w.y = cvt_pk_bf16(a[2], a[3]); w.z = cvt_pk_bf16(b[0], b[1]); w.w = cvt_pk_bf16(b[2], b[3]);
        *(u32x4*)(mh + (size_t)i * 8) = w; }
    asm volatile("s_waitcnt vmcnt(0)" ::: "memory");
    __syncthreads();
    if (c.tid == 0) { __builtin_amdgcn_fence(__ATOMIC_RELEASE, "agent"); asm volatile("s_waitcnt vmcnt(0)" ::: "memory"); (void)xb_add(cnt, 1u); }
}

template <int PH, bool RERUN>
__device__ __forceinline__ void run_phase(unsigned char* shm, int vbid, int wave_s) {
    unsigned z_ = 0u; int ws_ = wave_s; asm volatile("" : "+s"(z_)); asm volatile("" : "+s"(ws_));
    int tid_ = (ws_ << 6) | (int)__builtin_amdgcn_mbcnt_hi(~0u, __builtin_amdgcn_mbcnt_lo(~0u, z_)), bid_ = __builtin_amdgcn_readfirstlane(vbid);
    KParams pp_ = (KParams)__builtin_amdgcn_kernarg_segment_ptr();
    asm volatile("" : "+v"(tid_)); asm volatile("" : "+s"(bid_)); asm volatile("" : "+s"(pp_));
    Ctx c; c.p = pp_; c.ws = pp_->ws; c.bid = bid_; c.G = gridDim.x; c.tid = tid_; c.lane = tid_ & 63; c.wave = tid_ >> 6;
    LAS unsigned char* lds3 = (LAS unsigned char*)shm;
    if constexpr (PH == 0) { if (PH_EN(10)) phase_prep(c, (float*)shm); }
    else if constexpr (PH == NPH - 1) { if (PH_EN(11)) phase_final(c); }
    else {
        constexpr int l = (PH - 1) / PH_PER_LAYER, s = (PH - 1) % PH_PER_LAYER;
        constexpr bool last = (l == 1);
        const float* mod = c.fp(WS_MOD) + (size_t)l * 5 * MODW;
        constexpr int rows = last ? TL : TT;
        if constexpr (s == 0) { if (PH_EN(0)) phase_norm(c, l == 0 ? (const void*)c.p->in[0] : (const void*)c.bfp(WS_XW), l == 0, l == 0 ? (const void*)c.p->in[2] : (const void*)(c.bfp(WS_XW) + (size_t)TL * DM), l == 0, c.p->in[6] + l * DM, mod, 0, DM, c.bfp(WS_H), TT, l == 0 ? nullptr : c.fp(WS_Z));
                                if (last) weights_range(c, 1, (c.G == 256 ? WTC_END : 0) + c.bid, c.G, WT_TILES, 1 << 30, (float*)shm); }
        if constexpr (s == 1) { if (PH_EN(1)) { pg8::Order S; S.init(rows, IN_DIM, DM, c.G, c.bid, c.bfp(WS_H), c.bfp(WS_WIN + l * SZ_WIN));
                  if (last) { S.xM0 = 32; S.xnM = 4; S.xN0 = 8; S.xnN = 4; S.xsplit = 8; }
                  pg8::EpiBf16 E; E.O = c.bfp(WS_Z); E.ldc = IN_DIM; E.PART = c.fp(WS_AM + (size_t)2 * TT * 1024 * 2); E.U = c.bfp(WS_AM); E.V = c.bfp(WS_V);
                  pg8::gemm_phase(lds3, c.tid, DM, S, E);
                  if (!last && c.G == 256 && c.bid >= 224) weights_range(c, 1, c.bid - 224, 32, WTA_END, WTA_N, (float*)shm); } }
        if constexpr (s == 2) { if (PH_EN(2)) phase_post(c, l, !last); }
        if constexpr (s == 3) { if (PH_EN(3)) phase_attn(c, l, !last, (char*)shm, RERUN); }
        if constexpr (s == 4) { if (PH_EN(4)) { pg8::Order S; S.init(TL, DM, 1024, c.G, c.bid, c.bfp(WS_AM), c.bfp(WS_WM + l * SZ_WM));
                  S.nseg = 4; S.segA = (size_t)TT * 1024 * 2; S.segB = SZ_WM / 4;
                  if (!last) { S.xM0 = 32; S.xnM = 4; S.xN0 = 0; S.xnN = 8; S.xseg = 4; }
                  pg8::EpiMerge E; E.O = c.bfp(WS_H); E.Z = c.bfp(WS_Z); E.PARTM = c.fp(WS_Q);
                  pg8::gemm_phase(lds3, c.tid, 1024, S, E);
                  if (!last && c.G == 256 && c.bid >= 128) weights_range(c, 1, WTA_END + c.bid - 128, 128, WTB_END, WTB_N, (float*)shm); } }
        if constexpr (s == 5) { if (PH_EN(5)) { pg8::Order S; S.init(TL, DM, DM, c.G, c.bid, c.bfp(WS_H), c.bfp(WS_WO + l * SZ_WO));
                  if (!last) { S.xM0 = 32; S.xnM = 4; S.xN0 = 0; S.xnN = 8; S.xsplit = 8; S.wait_cnt = (unsigned*)(c.ws + WS_BAR) + 96; S.wait_need = (unsigned)c.G;
                               ctx_m_convert(c, S.wait_cnt); }
                  pg8::EpiResid E; E.X = c.bfp(WS_XW); E.Xf32 = l == 0 ? c.p->in[0] : nullptr; E.mod = mod; E.gate_off = 2 * DM; E.PART = c.fp(WS_Z);
                  pg8::gemm_phase(lds3, c.tid, DM, S, E); } }
        if constexpr (s == 6) { if (PH_EN(6)) phase_norm(c, c.bfp(WS_XW), false, c.p->in[2], true, c.p->in[18] + l * DM, mod, 3 * DM, 4 * DM, c.bfp(WS_H), rows, last ? nullptr : c.fp(WS_Z)); }
        if constexpr (s == 7) { if (PH_EN(7)) { pg8::Order S; S.init(rows, DFF2, DM, c.G, c.bid, c.bfp(WS_H), c.bfp(WS_WUP + l * SZ_WUP));
                  pg8::EpiFfn E; E.G = c.bfp(WS_AM); E.EDGE = c.fp(WS_EDGE); E.wcv = c.p->in[20] + (size_t)l * 3 * DFF2;
                  pg8::gemm_phase(lds3, c.tid, DM, S, E);
                  if (!last && c.G == 256 && c.bid >= 12) weights_range(c, 1, WTB_END + c.bid - 12, 244, WTC_END, WTC_N, (float*)shm); } }
        if constexpr (s == 8) { if (PH_EN(8)) phase_ffnfix(c, l, rows); }
        if constexpr (s == 9) { if (PH_EN(9)) { pg8::Order S; S.init(TL, DM, DFF, c.G, c.bid, c.bfp(WS_AM), c.bfp(WS_WDN + l * SZ_WDN));
                  if (!last) { S.xM0 = 32; S.xnM = 4; S.xN0 = 0; S.xnN = 8; S.xsplit = 8; }
                  pg8::EpiResid E; E.X = c.bfp(WS_XW); E.Xf32 = nullptr; E.mod = mod; E.gate_off = 5 * DM; E.PART = c.fp(WS_Z);
                  pg8::gemm_phase(lds3, c.tid, DFF, S, E); } }
    }
}

__global__ void __launch_bounds__(NTHR, 2) mega(Params p) {
    extern __shared__ __attribute__((aligned(16))) unsigned char shm[];
    cg::grid_group grid = cg::this_grid();
    volatile LAS unsigned* st = (volatile LAS unsigned*)((LAS unsigned char*)shm + LDS_GEMM);
    const int wave_s = __builtin_amdgcn_readfirstlane((int)threadIdx.x >> 6);
    const bool t0 = wave_s == 0 && lane_id_() == 0;
    if (t0) { st[0] = 0u; st[1] = 0u; }
    __syncthreads();
    const XcdBarrier xb = xcd_barrier_post((unsigned*)(p.ws + WS_BAR), st, wave_s);
#ifndef DBL_MASK
#define DBL_MASK 0
#endif
    int vbid = blockIdx.x;
    if (t0) st[2] = xb_add((unsigned*)(p.ws + WS_BAR) + 64 + xb.x, 1u);
    if (p.ph_hi < 0) grid.sync();
#define STEP(k) { if ((k) == 1) { xcd_barrier(xb); \
            unsigned* tk = (unsigned*)(p.ws + WS_BAR) + 64; bool ok = (gridDim.x & 7) == 0; \
            for (int j = 0; j < 8; ++j) ok = ok && (xb_ld(tk + j) == gridDim.x / 8); \
            if (ok) vbid = (int)(st[2] * 8u + xb.x); } \
        else if ((k) > 1) xcd_barrier(xb); run_phase<(k), false>(shm, (k) == 0 ? (int)blockIdx.x : vbid, wave_s); \
        if ((DBL_MASK >> (k)) & 1) { xcd_barrier(xb); run_phase<(k), true>(shm, (k) == 0 ? (int)blockIdx.x : vbid, wave_s); } }
    STEP(0) STEP(1) STEP(2) STEP(3) STEP(4) STEP(5) STEP(6) STEP(7) STEP(8) STEP(9) STEP(10)
    STEP(11) STEP(12) STEP(13) STEP(14) STEP(15) STEP(16) STEP(17) STEP(18) STEP(19) STEP(20) STEP(21)
#undef STEP
}

#ifndef MK_MULTI
#define MK_MULTI 0
#endif
extern "C" void kernel_launch(void* const* d_in, const int* in_sizes, int n_in, void* d_out, int out_size, void* d_ws, size_t ws_size, hipStream_t stream) {
    static int grid = 0;
    if (grid == 0) {
        if (n_in != 23 || out_size != TL * DM || ws_size < WS_END) { fprintf(stderr, "kernel_launch: unexpected shapes (n_in %d out %d ws %zu need %zu)\n", n_in, out_size, ws_size, (size_t)WS_END); grid = -1; return; }
        int dev = 0, cus = 0, per_cu = 0;
        hipGetDevice(&dev); hipDeviceGetAttribute(&cus, hipDeviceAttributeMultiprocessorCount, dev);
        if (hipFuncSetAttribute((const void*)mega, hipFuncAttributeMaxDynamicSharedMemorySize, LDS_BYTES) != hipSuccess) { fprintf(stderr, "kernel_launch: hipFuncSetAttribute failed\n"); grid = -1; return; }
        if (hipOccupancyMaxActiveBlocksPerMultiprocessor(&per_cu, (const void*)mega, NTHR, LDS_BYTES) != hipSuccess || per_cu < 1) { fprintf(stderr, "kernel_launch: occupancy query says %d\n", per_cu); per_cu = 1; }
        (void)hipGetLastError();
        grid = cus * 1;
        if (grid <= 0) grid = 256;
    }
    if (grid < 0) return;
    if (hipMemsetAsync((unsigned char*)d_ws + WS_BAR, 0, (size_t)XCD_BAR_WORDS * 4, stream) != hipSuccess) { fprintf(stderr, "kernel_launch: memset of barrier words failed\n"); return; }
    Params p{};
    for (int i = 0; i < 23; ++i) p.in[i] = (const float*)d_in[i];
    p.out = (float*)d_out; p.ws = (unsigned char*)d_ws;
    p.ph_lo = 0; p.ph_hi = NPH;
    void* args[] = {&p};
    hipError_t e = hipLaunchCooperativeKernel((const void*)mega, dim3(grid), dim3(NTHR), args, LDS_BYTES, stream);
    if (e != hipSuccess) fprintf(stderr, "kernel_launch: cooperative launch failed: %s (grid %d)\n", hipGetErrorString(e), grid);
}
```
